# Optimizing an MI355X kernel written in HIP

```python
import math
import jax, jax.numpy as jnp
from jax import lax
import numpy as np

D_MODEL = 1024
BATCH = 8
SEQ = 4096
DEPTH = 2
DEC_BATCH = 8
DEC_SEQ = 64
PAST_LEN = 1024

CHUNK = 64
N_META = 16
SCAN_BLOCK = CHUNK
MIX_WIDTH = D_MODEL
SSM_WIDTH = MIX_WIDTH // 2
SSM_HEADDIM = 64
SSM_HEADS = SSM_WIDTH // SSM_HEADDIM
SSM_GROUPS = 2
SSM_STATE = 128
CONV_WIDTH = 4
CONV_CH = SSM_WIDTH + 2 * SSM_GROUPS * SSM_STATE
HG_WIDTH = MIX_WIDTH - SSM_WIDTH
HG_EXPAND = 128
HG_HEADS = HG_WIDTH // HG_EXPAND
HG_VDIM = HG_WIDTH // HG_HEADS
IN_SPLITS = tuple(np.cumsum([SSM_WIDTH, CONV_CH, SSM_HEADS, HG_WIDTH, HG_WIDTH, HG_WIDTH]).tolist())
IN_COLS = SSM_WIDTH + CONV_CH + SSM_HEADS + 4 * HG_WIDTH
D_FF = 2816
EPS = 1e-6
LB_FLOOR = 1e-30

kernel_name = "hymba_ssd_hgrn2_macaron_stream"


def _rmsnorm(x, w, groups=1):
    xf = x.astype(jnp.float32)
    shp = xf.shape
    xg = xf.reshape(shp[:-1] + (groups, shp[-1] // groups))
    xg = xg * lax.rsqrt(jnp.mean(xg * xg, axis=-1, keepdims=True) + EPS)
    return (xg.reshape(shp) * w.astype(jnp.float32)).astype(x.dtype)


def _swiglu(x, w_gate, w_up, w_down):
    return (jax.nn.silu(x @ w_gate) * (x @ w_up)) @ w_down


def _causal_conv(u, buf, w, b):
    L = u.shape[1]
    xp = jnp.concatenate([buf.astype(u.dtype), u], axis=1)
    out = b + xp[:, 0:L] * w[0]
    for k in range(1, CONV_WIDTH):
        out = out + xp[:, k:k + L] * w[k]
    return out, xp[:, xp.shape[1] - (CONV_WIDTH - 1):]


def _pad(a, Lp):
    return jnp.pad(a, [(0, 0), (0, Lp - a.shape[1])] + [(0, 0)] * (a.ndim - 2))


def _to_blocks(a, nb):
    bt = a.shape[0]
    return jnp.moveaxis(a.reshape((bt, nb, SCAN_BLOCK) + a.shape[2:]), 1, 0)


def _masked_decay(seg, causal):
    return jnp.where(causal, jnp.exp(jnp.where(causal, seg, 0.0)), 0.0)


def _ssd_scan(xdt, la, bm, cm, s0):
    bt, L, H, P = xdt.shape
    G, N = bm.shape[2], bm.shape[3]
    R = H // G
    nb = L // SCAN_BLOCK
    causal = jnp.tril(jnp.ones((SCAN_BLOCK, SCAN_BLOCK), bool))[None, :, :, None, None]
    xs = (_to_blocks(xdt.reshape(bt, L, G, R, P), nb), _to_blocks(la.reshape(bt, L, G, R), nb),
          _to_blocks(bm, nb), _to_blocks(cm, nb))

    def step(S, blk):
        xb, lab, bb, cb = blk
        cum = jnp.cumsum(lab, axis=1)
        seg = cum[:, :, None] - cum[:, None]
        decay = _masked_decay(seg, causal)
        cbm = jnp.einsum('bign,bjgn->bijg', cb, bb)
        y = jnp.einsum('bijg,bijgr,bjgrp->bigrp', cbm, decay, xb)
        y = y + jnp.einsum('bign,bgrpn,bigr->bigrp', cb, S, jnp.exp(cum))
        last = cum[:, -1]
        S = jnp.exp(last)[..., None, None] * S + jnp.einsum(
            'bjgn,bjgr,bjgrp->bgrpn', bb, jnp.exp(last[:, None] - cum), xb)
        return S, y

    S, ys = lax.scan(step, s0.reshape(bt, G, R, P, N), xs)
    y = jnp.moveaxis(ys, 0, 1).reshape(bt, L, H, P)
    return y, S.reshape(bt, H, P, N)


def _gla_scan(q, k, v, lf, s0):
    bt, L, H, K = q.shape
    nb = L // SCAN_BLOCK
    causal = jnp.tril(jnp.ones((SCAN_BLOCK, SCAN_BLOCK), bool))[None, :, :, None, None]
    xs = (_to_blocks(q, nb), _to_blocks(k, nb), _to_blocks(v, nb), _to_blocks(lf, nb))

    def step(S, blk):
        qb, kb, vb, fb = blk
        cum = jnp.cumsum(fb, axis=1)
        seg = cum[:, :, None] - cum[:, None]
        decay = _masked_decay(seg, causal)
        att = jnp.einsum('bihk,bjhk,bijhk->bijh', qb, kb, decay)
        o = jnp.einsum('bijh,bjhv->bihv', att, vb) + jnp.einsum('bihk,bhkv->bihv', qb * jnp.exp(cum), S)
        last = cum[:, -1]
        S = jnp.exp(last)[..., None] * S + jnp.einsum(
            'bjhk,bjhv->bhkv', kb * jnp.exp(last[:, None] - cum), vb)
        return S, o

    S, os_ = lax.scan(step, s0, xs)
    return jnp.moveaxis(os_, 0, 1).reshape(bt, L, H, v.shape[-1]), S


def _mixer(hn, conv_buf, ssm_s, hg_s, w_in, conv_w, conv_b, dt_bias, a_log, d_skip,
           ssm_norm_w, hg_lb, hg_norm_w, w_out):
    f32 = jnp.float32
    bt, L, _ = hn.shape
    Lp = -(-L // SCAN_BLOCK) * SCAN_BLOCK
    proj = hn @ w_in
    z, xbc, dt_raw, hq, hf, hi, hg = jnp.split(proj, IN_SPLITS, axis=-1)

    xbc, new_conv = _causal_conv(xbc, conv_buf, conv_w, conv_b)
    xbc = jax.nn.silu(xbc).astype(f32)
    xs, bm, cm = jnp.split(xbc, [SSM_WIDTH, SSM_WIDTH + SSM_GROUPS * SSM_STATE], axis=-1)
    xs = xs.reshape(bt, L, SSM_HEADS, SSM_HEADDIM)
    bm = bm.reshape(bt, L, SSM_GROUPS, SSM_STATE)
    cm = cm.reshape(bt, L, SSM_GROUPS, SSM_STATE)
    dt = jax.nn.softplus(dt_raw.astype(f32) + dt_bias.astype(f32))
    a = -jnp.exp(a_log.astype(f32))
    y, new_ssm = _ssd_scan(_pad(xs * dt[..., None], Lp), _pad(dt * a, Lp), _pad(bm, Lp), _pad(cm, Lp),
                           ssm_s.astype(f32))
    y = y[:, :L] + d_skip.astype(f32)[:, None] * xs
    y = y.reshape(bt, L, SSM_WIDTH) * jax.nn.silu(z.astype(f32))
    y_ssm = _rmsnorm(y, ssm_norm_w, SSM_GROUPS)

    q = jax.nn.silu(hq.astype(f32)).reshape(bt, L, HG_HEADS, HG_EXPAND)
    fr = hf.astype(f32)
    lf = jnp.logaddexp(jnp.log(jnp.maximum(hg_lb, LB_FLOOR)), jnp.log1p(-hg_lb) + jax.nn.log_sigmoid(fr))
    kk = (1.0 - hg_lb) * jax.nn.sigmoid(-fr)
    v = hi.astype(f32).reshape(bt, L, HG_HEADS, HG_VDIM)
    o, new_hg = _gla_scan(_pad(q, Lp), _pad(kk.reshape(bt, L, HG_HEADS, HG_EXPAND), Lp), _pad(v, Lp),
                          _pad(lf.reshape(bt, L, HG_HEADS, HG_EXPAND), Lp), hg_s.astype(f32))
    o = _rmsnorm(o[:, :L], hg_norm_w.reshape(HG_HEADS, HG_VDIM))
    o = o.reshape(bt, L, HG_WIDTH) * jax.nn.silu(hg.astype(f32))

    mixed = jnp.concatenate([y_ssm, o], axis=-1).astype(hn.dtype) @ w_out
    return (mixed, new_conv.astype(conv_buf.dtype), new_ssm.astype(ssm_s.dtype), new_hg.astype(hg_s.dtype))


def _trunk(h, conv_st, ssm_st, hg_st, p):
    (ln_ffa_w, ffa_w_gate, ffa_w_up, ffa_w_down, ln_mix_w, w_in, conv_w, conv_b, dt_bias, a_log, d_skip,
     ssm_norm_w, hg_lb, hg_norm_w, w_out, ln_ffb_w, ffb_w_gate, ffb_w_up, ffb_w_down, ln_f_w) = p
    conv_new, ssm_new, hg_new = [], [], []
    for l in range(DEPTH):
        h = h + 0.5 * _swiglu(_rmsnorm(h, ln_ffa_w[l]), ffa_w_gate[l], ffa_w_up[l], ffa_w_down[l])
        m, c, s, g = _mixer(_rmsnorm(h, ln_mix_w[l]), conv_st[l], ssm_st[l], hg_st[l], w_in[l], conv_w[l],
                            conv_b[l], dt_bias[l], a_log[l], d_skip[l], ssm_norm_w[l], hg_lb[l], hg_norm_w[l],
                            w_out[l])
        h = h + m
        h = h + 0.5 * _swiglu(_rmsnorm(h, ln_ffb_w[l]), ffb_w_gate[l], ffb_w_up[l], ffb_w_down[l])
        conv_new.append(c)
        ssm_new.append(s)
        hg_new.append(g)
    return _rmsnorm(h, ln_f_w), jnp.stack(conv_new), jnp.stack(ssm_new), jnp.stack(hg_new)


def setup_inputs(seed: int = 0) -> dict:
    key = jax.random.key(seed)
    ks = jax.random.split(key, 32)
    f32 = jnp.float32

    def nrm(k, shape, s):
        return s * jax.random.normal(k, shape, f32)

    dt0 = jnp.exp(jax.random.uniform(ks[12], (DEPTH, SSM_HEADS), f32, math.log(1e-3), math.log(1e-1)))
    return {
        "x_prompt": nrm(ks[0], (BATCH, SEQ, D_MODEL), 1.0),
        "x_sample": nrm(ks[1], (DEC_BATCH, DEC_SEQ, D_MODEL), 1.0),
        "state_conv": nrm(ks[2], (DEPTH, DEC_BATCH, CONV_WIDTH - 1, CONV_CH), 1.0),
        "state_ssm": nrm(ks[3], (DEPTH, DEC_BATCH, SSM_HEADS, SSM_HEADDIM, SSM_STATE), 0.5),
        "state_hgrn": nrm(ks[4], (DEPTH, DEC_BATCH, HG_HEADS, HG_EXPAND, HG_VDIM), 0.5),
        "meta_tokens": nrm(ks[5], (N_META, D_MODEL), 1.0),
        "ln_ffa_w": 1.0 + nrm(ks[6], (DEPTH, D_MODEL), 0.01),
        "ffa_w_gate": nrm(ks[7], (DEPTH, D_MODEL, D_FF), D_MODEL ** -0.5),
        "ffa_w_up": nrm(ks[8], (DEPTH, D_MODEL, D_FF), D_MODEL ** -0.5),
        "ffa_w_down": nrm(ks[9], (DEPTH, D_FF, D_MODEL), D_FF ** -0.5),
        "ln_mix_w": 1.0 + nrm(ks[10], (DEPTH, D_MODEL), 0.01),
        "w_in": nrm(ks[11], (DEPTH, D_MODEL, IN_COLS), D_MODEL ** -0.5),
        "conv_w": nrm(ks[13], (DEPTH, CONV_WIDTH, CONV_CH), CONV_WIDTH ** -0.5),
        "conv_b": nrm(ks[14], (DEPTH, CONV_CH), 0.01),
        "dt_bias": dt0 + jnp.log(-jnp.expm1(-dt0)),
        "a_log": jnp.log(jax.random.uniform(ks[15], (DEPTH, SSM_HEADS), f32, 1.0, 16.0)),
        "d_skip": 1.0 + nrm(ks[16], (DEPTH, SSM_HEADS), 0.01),
        "ssm_norm_w": 1.0 + nrm(ks[17], (DEPTH, SSM_WIDTH), 0.01),
        "hg_lb_raw": nrm(ks[18], (DEPTH, HG_WIDTH), 0.1),
        "hg_norm_w": 1.0 + nrm(ks[19], (DEPTH, HG_WIDTH), 0.01),
        "w_out": nrm(ks[20], (DEPTH, MIX_WIDTH, D_MODEL), MIX_WIDTH ** -0.5),
        "ln_ffb_w": 1.0 + nrm(ks[21], (DEPTH, D_MODEL), 0.01),
        "ffb_w_gate": nrm(ks[22], (DEPTH, D_MODEL, D_FF), D_MODEL ** -0.5),
        "ffb_w_up": nrm(ks[23], (DEPTH, D_MODEL, D_FF), D_MODEL ** -0.5),
        "ffb_w_down": nrm(ks[24], (DEPTH, D_FF, D_MODEL), D_FF ** -0.5),
        "ln_f_w": 1.0 + nrm(ks[25], (D_MODEL,), 0.01),
    }


def reference(x_prompt, x_sample, state_conv, state_ssm, state_hgrn, meta_tokens, ln_ffa_w, ffa_w_gate,
              ffa_w_up, ffa_w_down, ln_mix_w, w_in, conv_w, conv_b, dt_bias, a_log, d_skip, ssm_norm_w,
              hg_lb_raw, hg_norm_w, w_out, ln_ffb_w, ffb_w_gate, ffb_w_up, ffb_w_down, ln_f_w):
    sm = jax.nn.softmax(hg_lb_raw.astype(jnp.float32), axis=0)
    hg_lb = jnp.clip(jnp.cumsum(sm, axis=0) - sm[0], 0.0, 1.0 - 1e-6)
    params = (ln_ffa_w, ffa_w_gate, ffa_w_up, ffa_w_down, ln_mix_w, w_in, conv_w, conv_b, dt_bias, a_log,
              d_skip, ssm_norm_w, hg_lb, hg_norm_w, w_out, ln_ffb_w, ffb_w_gate, ffb_w_up, ffb_w_down, ln_f_w)

    b = x_prompt.shape[0]
    dt_ = x_prompt.dtype
    meta = jnp.broadcast_to(meta_tokens.astype(dt_)[None], (b, N_META, D_MODEL))
    h0 = jnp.concatenate([meta, x_prompt], axis=1)
    zc = jnp.zeros((DEPTH, b, CONV_WIDTH - 1, CONV_CH), dt_)
    zs = jnp.zeros((DEPTH, b, SSM_HEADS, SSM_HEADDIM, SSM_STATE), dt_)
    zg = jnp.zeros((DEPTH, b, HG_HEADS, HG_EXPAND, HG_VDIM), dt_)
    hp, conv_p, ssm_p, hg_p = _trunk(h0, zc, zs, zg, params)
    y_prompt = hp[:, N_META:]

    y_sample, conv_s, ssm_s, hg_s = _trunk(x_sample, state_conv, state_ssm, state_hgrn, params)
    return (y_prompt, y_sample, conv_p, ssm_p, hg_p, conv_s, ssm_s, hg_s)
```

```cpp
#include <hip/hip_runtime.h>
#include <hip/hip_bf16.h>
#include <hip/hip_cooperative_groups.h>
#include <cstdio>
namespace cg = cooperative_groups;

#ifndef SINGLE_LAUNCH
#define SINGLE_LAUNCH 0
#endif

typedef unsigned short bfr;
using bf16x8 = __attribute__((ext_vector_type(8))) short;
using f32x4  = __attribute__((ext_vector_type(4))) float;
using u32x4  = __attribute__((ext_vector_type(4))) unsigned;

constexpr int T_ROWS = 33792;
constexpr int PROW = 4160, PLEN = 4112, SROW0 = 33280;
constexpr int DM = 1024, DFF = 2816, NGU = 5632, NIN = 3584, NINP = 3840;
constexpr float EPSF = 1e-6f;
constexpr size_t OFF_HB = 0;
constexpr size_t OFF_RS = 69206016;
constexpr size_t OFF_DT = 69341184;
constexpr size_t OFF_U = 70422528;
constexpr size_t OFF_MIX = 312643584;
constexpr size_t OFF_W = 381849600;
constexpr size_t W_GUA = 0, W_DA = 5767168, W_IN = 8650752, W_OUT = 12582912, W_GUB = 13631488, W_DB = 19398656, W_LAYER = 22282240;
constexpr size_t O_YP = 0, O_YS = 33554432, O_CP = 34078720, O_SP = 34127872, O_HP = 35176448, O_CS = 36225024, O_SS = 36274176, O_HS = 37322752;
constexpr int LDS_BYTES = 131072;
constexpr int NPHASE = 23;

struct KP {
  const float* in[26];
  float* out;
  unsigned char* ws;
  int ph_lo, ph_hi;
};

__device__ __forceinline__ bfr f2bf(float f) {
  unsigned u = __float_as_uint(f);
  u += 0x7fffu + ((u >> 16) & 1u);
  return (bfr)(u >> 16);
}
__device__ __forceinline__ float bf2f(bfr b) { return __uint_as_float(((unsigned)b) << 16); }
__device__ __forceinline__ float siluf(float x) { return x / (1.f + __expf(-x)); }
__device__ __forceinline__ unsigned pack2(float a, float b) { return (unsigned)f2bf(a) | ((unsigned)f2bf(b) << 16); }

__device__ void phase_prep(const KP& p) {
  extern __shared__ __attribute__((aligned(16))) unsigned char smem[];
  float* tile = (float*)smem;
  int tid = threadIdx.x; asm volatile("" : "+v"(tid));
  bfr* W = (bfr*)(p.ws + OFF_W);
  for (int job = blockIdx.x; job < 2 * 5440; job += gridDim.x) {
    int l = job / 5440, j = job % 5440;
    int mat, nt, kt, K; size_t woff;
    const float *s0, *s1, *sc; int ldn; float cs;
    if (j < 1408) { mat = 0; nt = j / 16; kt = j % 16; K = DM; woff = W_GUA; s0 = p.in[7] + (size_t)l * DM * DFF; s1 = p.in[8] + (size_t)l * DM * DFF; sc = p.in[6] + l * DM; ldn = DFF; cs = 1.f; }
    else if (j < 2112) { j -= 1408; mat = 1; nt = j / 44; kt = j % 44; K = DFF; woff = W_DA; s0 = s1 = p.in[9] + (size_t)l * DFF * DM; sc = nullptr; ldn = DM; cs = 0.5f; }
    else if (j < 3072) { j -= 2112; mat = 2; nt = j / 16; kt = j % 16; K = DM; woff = W_IN; s0 = s1 = p.in[11] + (size_t)l * DM * 3592; sc = p.in[10] + l * DM; ldn = 3592; cs = 1.f; }
    else if (j < 3328) { j -= 3072; mat = 3; nt = j / 16; kt = j % 16; K = DM; woff = W_OUT; s0 = s1 = p.in[20] + (size_t)l * DM * DM; sc = nullptr; ldn = DM; cs = 1.f; }
    else if (j < 4736) { j -= 3328; mat = 0; nt = j / 16; kt = j % 16; K = DM; woff = W_GUB; s0 = p.in[22] + (size_t)l * DM * DFF; s1 = p.in[23] + (size_t)l * DM * DFF; sc = p.in[21] + l * DM; ldn = DFF; cs = 1.f; }
    else { j -= 4736; mat = 1; nt = j / 44; kt = j % 44; K = DFF; woff = W_DB; s0 = s1 = p.in[24] + (size_t)l * DFF * DM; sc = nullptr; ldn = DM; cs = 0.5f; }
    int n0 = nt * 64, k0 = kt * 64;
    for (int it = 0; it < 8; ++it) {
      int e = tid + 512 * it, kk = e >> 6, nn = e & 63;
      int k = k0 + kk, n = n0 + nn, c = n; bool ok = true; const float* sp = s0;
      if (mat == 0) { int r = n & 31; c = (n >> 5) * 16 + (r & 15); if (r >= 16) sp = s1; }
      else if (mat == 2) { if (n < 1536) c = n; else if (n < 3584) c = n + 8; else if (n < 3592) c = 1536 + (n - 3584); else { ok = false; c = 0; } }
      float v = sp[(size_t)k * ldn + c] * cs;
      if (sc) v *= sc[k];
      tile[kk * 65 + nn] = ok ? v : 0.f;
    }
    __syncthreads();
    {
      int nn = tid >> 3, seg = tid & 7;
      u32x4 v;
      v[0] = pack2(tile[(seg * 8 + 0) * 65 + nn], tile[(seg * 8 + 1) * 65 + nn]);
      v[1] = pack2(tile[(seg * 8 + 2) * 65 + nn], tile[(seg * 8 + 3) * 65 + nn]);
      v[2] = pack2(tile[(seg * 8 + 4) * 65 + nn], tile[(seg * 8 + 5) * 65 + nn]);
      v[3] = pack2(tile[(seg * 8 + 6) * 65 + nn], tile[(seg * 8 + 7) * 65 + nn]);
      *(u32x4*)(W + (size_t)l * W_LAYER + woff + (size_t)(n0 + nn) * K + k0 + seg * 8) = v;
    }
    __syncthreads();
  }
}

__device__ __forceinline__ float wave_sum(float v) {
#pragma unroll
  for (int o = 32; o >= 1; o >>= 1) v += __shfl_xor(v, o);
  return v;
}

__device__ void phase_init(const KP& p) {
  int tid_ = threadIdx.x; asm volatile("" : "+v"(tid_));
  const int lane = tid_ & 63, w = tid_ >> 6;
  bfr* hb = (bfr*)(p.ws + OFF_HB);
  float* rs = (float*)(p.ws + OFF_RS);
  for (int row = blockIdx.x * 8 + w; row < T_ROWS; row += gridDim.x * 8) {
    const float* src = nullptr;
    if (row < SROW0) {
      int s = row / PROW, pos = row % PROW;
      if (pos < 16) src = p.in[5] + (size_t)pos * DM;
      else if (pos < PLEN) src = p.in[0] + ((size_t)s * 4096 + (pos - 16)) * DM;
    } else src = p.in[1] + (size_t)(row - SROW0) * DM;
    float ss = 0.f;
#pragma unroll
    for (int i = 0; i < 4; ++i) {
      int c = 4 * (lane + 64 * i);
      float4 v = src ? *(const float4*)(src + c) : make_float4(0.f, 0.f, 0.f, 0.f);
      bfr b0 = f2bf(v.x), b1 = f2bf(v.y), b2 = f2bf(v.z), b3 = f2bf(v.w);
      float r0 = bf2f(b0), r1 = bf2f(b1), r2 = bf2f(b2), r3 = bf2f(b3);
      ss += r0 * r0 + r1 * r1 + r2 * r2 + r3 * r3;
      uint2 o; o.x = (unsigned)b0 | ((unsigned)b1 << 16); o.y = (unsigned)b2 | ((unsigned)b3 << 16);
      *(uint2*)(hb + (size_t)row * DM + c) = o;
    }
    ss = wave_sum(ss);
    if (lane == 0) rs[row] = rsqrtf(ss * (1.f / DM) + EPSF);
  }
}

__device__ void phase_stat(const KP& p) {
  int tid_ = threadIdx.x; asm volatile("" : "+v"(tid_));
  const int lane = tid_ & 63, w = tid_ >> 6;
  const bfr* hb = (const bfr*)(p.ws + OFF_HB);
  float* rs = (float*)(p.ws + OFF_RS);
  for (int row = blockIdx.x * 8 + w; row < T_ROWS; row += gridDim.x * 8) {
    float ss = 0.f;
#pragma unroll
    for (int i = 0; i < 2; ++i) {
      u32x4 v = *(const u32x4*)(hb + (size_t)row * DM + lane * 8 + 512 * i);
#pragma unroll
      for (int e = 0; e < 4; ++e) {
        float a = __uint_as_float(v[e] << 16), b = __uint_as_float(v[e] & 0xffff0000u);
        ss += a * a + b * b;
      }
    }
    ss = wave_sum(ss);
    if (lane == 0) rs[row] = rsqrtf(ss * (1.f / DM) + EPSF);
  }
}

__device__ void phase_final(const KP& p) {
  int tid_ = threadIdx.x; asm volatile("" : "+v"(tid_));
  const int lane = tid_ & 63, w = tid_ >> 6;
  const bfr* hb = (const bfr*)(p.ws + OFF_HB);
  const float* lw = p.in[25];
  for (int row = blockIdx.x * 8 + w; row < T_ROWS; row += gridDim.x * 8) {
    float* dst;
    if (row < SROW0) {
      int s = row / PROW, pos = row % PROW;
      if (pos < 16 || pos >= PLEN) continue;
      dst = p.out + O_YP + ((size_t)s * 4096 + (pos - 16)) * DM;
    } else dst = p.out + O_YS + (size_t)(row - SROW0) * DM;
    float x[16];
    float ss = 0.f;
#pragma unroll
    for (int i = 0; i < 2; ++i) {
      u32x4 v = *(const u32x4*)(hb + (size_t)row * DM + lane * 8 + 512 * i);
#pragma unroll
      for (int e = 0; e < 4; ++e) {
        float a = __uint_as_float(v[e] << 16), b = __uint_as_float(v[e] & 0xffff0000u);
        x[i * 8 + e * 2] = a; x[i * 8 + e * 2 + 1] = b;
        ss += a * a + b * b;
      }
    }
    ss = wave_sum(ss);
    float r = rsqrtf(ss * (1.f / DM) + EPSF);
#pragma unroll
    for (int i = 0; i < 2; ++i) {
      int c = lane * 8 + 512 * i;
      float4 w0 = *(const float4*)(lw + c), w1 = *(const float4*)(lw + c + 4);
      float4 o0 = make_float4(x[i * 8 + 0] * r * w0.x, x[i * 8 + 1] * r * w0.y, x[i * 8 + 2] * r * w0.z, x[i * 8 + 3] * r * w0.w);
      float4 o1 = make_float4(x[i * 8 + 4] * r * w1.x, x[i * 8 + 5] * r * w1.y, x[i * 8 + 6] * r * w1.z, x[i * 8 + 7] * r * w1.w);
      *(float4*)(dst + c) = o0; *(float4*)(dst + c + 4) = o1;
    }
  }
}

__device__ void phase_mixnorm(const KP& p, int l) {
  int tid_ = threadIdx.x; asm volatile("" : "+v"(tid_));
  const int lane = tid_ & 63, w = tid_ >> 6;
  bfr* mix = (bfr*)(p.ws + OFF_MIX);
  const bfr* proj = (const bfr*)(p.ws + OFF_U);
  for (int row = blockIdx.x * 8 + w; row < T_ROWS; row += gridDim.x * 8) {
    bfr* mp = mix + (size_t)row * DM + lane * 16;
    u32x4 v0 = *(const u32x4*)mp, v1 = *(const u32x4*)(mp + 8);
    float x[16];
#pragma unroll
    for (int e = 0; e < 4; ++e) {
      x[e * 2] = __uint_as_float(v0[e] << 16); x[e * 2 + 1] = __uint_as_float(v0[e] & 0xffff0000u);
      x[8 + e * 2] = __uint_as_float(v1[e] << 16); x[8 + e * 2 + 1] = __uint_as_float(v1[e] & 0xffff0000u);
    }
    float ss = 0.f;
#pragma unroll
    for (int e = 0; e < 16; ++e) ss += x[e] * x[e];
    ss += __shfl_xor(ss, 1); ss += __shfl_xor(ss, 2); ss += __shfl_xor(ss, 4);
    float s8 = __shfl_xor(ss, 8);
    float r;
    if (lane < 32) r = rsqrtf((ss + s8) * (1.f / 256.f) + EPSF);
    else r = rsqrtf(ss * (1.f / 128.f) + EPSF);
    float o[16];
    if (lane < 32) {
      const float* nw = p.in[17] + l * 512 + lane * 16;
#pragma unroll
      for (int e = 0; e < 16; ++e) o[e] = x[e] * r * nw[e];
    } else {
      int cg0 = (lane - 32) * 16;
      const float* nw = p.in[19] + l * 512 + cg0;
      const bfr* gp = proj + (size_t)row * NIN + 3072 + cg0;
      u32x4 g0 = *(const u32x4*)gp, g1 = *(const u32x4*)(gp + 8);
      float g[16];
#pragma unroll
      for (int e = 0; e < 4; ++e) {
        g[e * 2] = __uint_as_float(g0[e] << 16); g[e * 2 + 1] = __uint_as_float(g0[e] & 0xffff0000u);
        g[8 + e * 2] = __uint_as_float(g1[e] << 16); g[8 + e * 2 + 1] = __uint_as_float(g1[e] & 0xffff0000u);
      }
#pragma unroll
      for (int e = 0; e < 16; ++e) o[e] = x[e] * r * nw[e] * siluf(g[e]);
    }
    u32x4 w0, w1;
#pragma unroll
    for (int e = 0; e < 4; ++e) { w0[e] = pack2(o[e * 2], o[e * 2 + 1]); w1[e] = pack2(o[8 + e * 2], o[8 + e * 2 + 1]); }
    *(u32x4*)mp = w0; *(u32x4*)(mp + 8) = w1;
  }
}

constexpr int BM = 256, BK = 64, HALF = 128, NXCD = 8, WGM = 16, HT = HALF * BK;

__device__ __forceinline__ int lds_byte(int r, int c) {
  int st = (r >> 4) * 2 + (c >> 5), rr = r & 15, cc = c & 31, ob = rr * 64 + cc * 2;
  return st * 1024 + (ob ^ (((ob >> 9) & 1) << 5));
}
__device__ __forceinline__ void stage_rc(int b, int& R, int& C) {
  int st = b / 1024, sb = b % 1024, swz = sb ^ (((sb >> 9) & 1) << 5);
  R = (st >> 1) * 16 + swz / 64; C = (st & 1) * 32 + (swz % 64) / 2;
}

template <int EPI, int N, int K>
__device__ __forceinline__ void gemm_phase(const KP& p, int l, const bfr* A, const bfr* Bt) {
  extern __shared__ __attribute__((aligned(16))) unsigned char smem[];
  bfr* shm = (bfr*)smem;
#define SA(b, h) (shm + ((b) * 2 + (h)) * HT)
#define SB(b, h) (shm + (4 + (b) * 2 + (h)) * HT)
#define STAGE_A(P, BASE, br, kt) do { const char* _gb = (const char*)((BASE) + (long)(br) * K + (long)(kt) * BK); \
    __builtin_amdgcn_global_load_lds((const unsigned*)(_gb + so0), (unsigned*)((char*)(P) + tid * 16), 16, 0, 0); } while (0)
#define STAGE_B(P, BASE, br, kt) do { const char* _gb = (const char*)((BASE) + (long)(br) * K + (long)(kt) * BK); \
    __builtin_amdgcn_global_load_lds((const unsigned*)(_gb + so0), (unsigned*)((char*)(P) + tid * 16), 16, 0, 0); \
    __builtin_amdgcn_global_load_lds((const unsigned*)(_gb + so1), (unsigned*)((char*)(P) + tid * 16 + 8192), 16, 0, 0); } while (0)
#define LDA(dst, b, h) for (int m = 0; m < 2; ++m) for (int k = 0; k < 2; ++k) \
    dst[m][k] = *reinterpret_cast<const bf16x8*>((char*)SA(b, h) + lds_byte(wr * 32 + m * 16 + fr, k * 32 + fq * 8))
#define LDB(dst, b, h) for (int n = 0; n < 2; ++n) for (int k = 0; k < 2; ++k) \
    dst[n][k] = *reinterpret_cast<const bf16x8*>((char*)SB(b, h) + lds_byte(wc * 32 + n * 16 + fr, k * 32 + fq * 8))
#define MMA(ai, bj, At, Bq) do { __builtin_amdgcn_s_setprio(1); \
    for (int m = 0; m < 2; ++m) for (int n = 0; n < 2; ++n) for (int k = 0; k < 2; ++k) \
      acc[ai][bj][m][n] = __builtin_amdgcn_mfma_f32_16x16x32_bf16(At[m][k], Bq[n][k], acc[ai][bj][m][n], 0, 0, 0); \
    __builtin_amdgcn_s_setprio(0); } while (0)
#define WAIT_V(n) asm volatile("s_waitcnt vmcnt(" #n ")" ::: "memory")
#define WAIT_L(n) asm volatile("s_waitcnt lgkmcnt(" #n ")" ::: "memory")
#define BAR __builtin_amdgcn_s_barrier()
#define SCHED __builtin_amdgcn_sched_barrier(0)

  constexpr int TM = 128, HM = 64;
  const int nM = T_ROWS / TM, nN = N / BM, nwg = nM * nN;
  int tid = threadIdx.x; asm volatile("" : "+v"(tid));
  const int wid = tid >> 6, lane = tid & 63, wr = wid >> 2, wc = wid & 3, fr = lane & 15, fq = lane >> 4;
  const int nt = K / BK;
  unsigned so0, so1;
  { int _r, _c; stage_rc(tid * 16, _r, _c); so0 = (unsigned)(_r * K + _c) * 2u; stage_rc(tid * 16 + 8192, _r, _c); so1 = (unsigned)(_r * K + _c) * 2u; }
  for (int Lt = blockIdx.x; Lt < nwg; Lt += gridDim.x) {
    int wgid = Lt;
    { int q = nwg / NXCD, r = nwg % NXCD, xcd = wgid % NXCD, off = wgid / NXCD;
      wgid = (xcd < r ? xcd * (q + 1) : r * (q + 1) + (xcd - r) * q) + off; }
    int nig = WGM * nN, gid = wgid / nig, fm = gid * WGM, gsz = min(nM - fm, WGM);
    int pm = fm + ((wgid % nig) % gsz), pn = (wgid % nig) / gsz, brow = pm * TM, bcol = pn * BM;
    f32x4 acc[2][2][2][2];
#pragma unroll
    for (int a = 0; a < 2; ++a)
#pragma unroll
      for (int b = 0; b < 2; ++b)
#pragma unroll
        for (int m = 0; m < 2; ++m)
#pragma unroll
          for (int n = 0; n < 2; ++n) acc[a][b][m][n] = f32x4{0.f, 0.f, 0.f, 0.f};
    bf16x8 At[2][2], B0[2][2], B1[2][2];
    STAGE_B(SB(0, 0), Bt, bcol, 0); STAGE_A(SA(0, 0), A, brow, 0);
    STAGE_B(SB(0, 1), Bt, bcol + HALF, 0); STAGE_A(SA(0, 1), A, brow + HM, 0);
    if (wr == 1) BAR;
    WAIT_V(3); BAR;
    STAGE_B(SB(1, 0), Bt, bcol, 1); STAGE_A(SA(1, 0), A, brow, 1); STAGE_B(SB(1, 1), Bt, bcol + HALF, 1);
    WAIT_V(5); BAR;
    for (int t = 0; t < nt - 2; t += 2) {
      LDB(B0, 0, 0); SCHED; LDA(At, 0, 0); STAGE_A(SA(1, 1), A, brow + HM, t + 1);
      WAIT_L(4); BAR; WAIT_L(0); MMA(0, 0, At, B0); BAR; SCHED;
      LDB(B1, 0, 1); STAGE_B(SB(0, 0), Bt, bcol, t + 2);
      BAR; WAIT_L(0); MMA(0, 1, At, B1); BAR;
      LDA(At, 0, 1); STAGE_A(SA(0, 0), A, brow, t + 2);
      BAR; WAIT_L(0); MMA(1, 0, At, B0); BAR; SCHED;
      STAGE_B(SB(0, 1), Bt, bcol + HALF, t + 2);
      WAIT_V(5); BAR; MMA(1, 1, At, B1); BAR;
      LDB(B0, 1, 0); SCHED; LDA(At, 1, 0); STAGE_A(SA(0, 1), A, brow + HM, t + 2);
      WAIT_L(4); BAR; WAIT_L(0); MMA(0, 0, At, B0); BAR; SCHED;
      LDB(B1, 1, 1); STAGE_B(SB(1, 0), Bt, bcol, t + 3);
      BAR; WAIT_L(0); MMA(0, 1, At, B1); BAR;
      LDA(At, 1, 1); STAGE_A(SA(1, 0), A, brow, t + 3);
      BAR; WAIT_L(0); MMA(1, 0, At, B0); BAR; SCHED;
      STAGE_B(SB(1, 1), Bt, bcol + HALF, t + 3);
      WAIT_V(5); BAR; MMA(1, 1, At, B1); BAR;
    }
    { LDB(B0, 0, 0); LDA(At, 0, 0); STAGE_A(SA(1, 1), A, brow + HM, nt - 1);
      BAR; WAIT_L(0); MMA(0, 0, At, B0); BAR;
      LDB(B1, 0, 1); BAR; WAIT_L(0); MMA(0, 1, At, B1); BAR;
      LDA(At, 0, 1); WAIT_V(3); BAR; WAIT_L(0); MMA(1, 0, At, B0); MMA(1, 1, At, B1); BAR; }
    { LDB(B0, 1, 0); LDA(At, 1, 0); WAIT_V(1); BAR; WAIT_L(0); MMA(0, 0, At, B0); BAR;
      LDB(B1, 1, 1); WAIT_V(0); BAR; WAIT_L(0); MMA(0, 1, At, B1); BAR;
      LDA(At, 1, 1); BAR; WAIT_L(0); MMA(1, 0, At, B0); MMA(1, 1, At, B1); BAR; }
    if (wr == 0) BAR;

    const float* rs = (const float*)(p.ws + OFF_RS);
    if (EPI == 1) {
      bfr* act = (bfr*)(p.ws + OFF_U);
#pragma unroll
      for (int ai = 0; ai < 2; ++ai)
#pragma unroll
        for (int m = 0; m < 2; ++m)
#pragma unroll
          for (int j = 0; j < 4; ++j) {
            int row = brow + ai * HM + wr * 32 + m * 16 + fq * 4 + j;
            float r = rs[row];
#pragma unroll
            for (int bj = 0; bj < 2; ++bj) {
              float g = acc[ai][bj][m][0][j] * r, u = acc[ai][bj][m][1][j] * r;
              int hc = (bcol >> 1) + bj * 64 + wc * 16 + fr;
              act[(size_t)row * DFF + hc] = f2bf(siluf(g) * u);
            }
          }
    } else if (EPI == 2) {
      bfr* hb = (bfr*)(p.ws + OFF_HB);
#pragma unroll
      for (int ai = 0; ai < 2; ++ai)
#pragma unroll
        for (int m = 0; m < 2; ++m)
#pragma unroll
          for (int j = 0; j < 4; ++j) {
            int row = brow + ai * HM + wr * 32 + m * 16 + fq * 4 + j;
#pragma unroll
            for (int bj = 0; bj < 2; ++bj)
#pragma unroll
              for (int n = 0; n < 2; ++n) {
                int col = bcol + bj * HALF + wc * 32 + n * 16 + fr;
                bfr* hp = hb + (size_t)row * DM + col;
                *hp = f2bf(bf2f(*hp) + acc[ai][bj][m][n][j]);
              }
          }
    } else {
      bfr* proj = (bfr*)(p.ws + OFF_U);
      float* dtb = (float*)(p.ws + OFF_DT);
#pragma unroll
      for (int ai = 0; ai < 2; ++ai)
#pragma unroll
        for (int m = 0; m < 2; ++m)
#pragma unroll
          for (int j = 0; j < 4; ++j) {
            int row = brow + ai * HM + wr * 32 + m * 16 + fq * 4 + j;
            float r = rs[row];
            if (pn < 14) {
              float* cdst = nullptr;
              if (bcol >= 512 && bcol < 1536) {
                if (row < SROW0) { int s = row / PROW, tl = row % PROW - (PLEN - 3); if (tl >= 0 && tl < 3) cdst = p.out + O_CP + ((size_t)(l * 8 + s) * 3 + tl) * 1024; }
                else { int s = (row - SROW0) >> 6, tl = ((row - SROW0) & 63) - 61; if (tl >= 0) cdst = p.out + O_CS + ((size_t)(l * 8 + s) * 3 + tl) * 1024; }
              }
#pragma unroll
              for (int bj = 0; bj < 2; ++bj)
#pragma unroll
                for (int n = 0; n < 2; ++n) {
                  int col = bcol + bj * HALF + wc * 32 + n * 16 + fr;
                  float v = acc[ai][bj][m][n][j] * r;
                  proj[(size_t)row * NIN + col] = f2bf(v);
                  if (cdst) cdst[col - 512] = v;
                }
            } else {
              if (wc == 0 && fr < 8) dtb[(size_t)row * 8 + fr] = acc[ai][0][m][0][j] * r;
            }
          }
    }
  }
#undef SA
#undef SB
#undef STAGE_A
#undef STAGE_B
#undef LDA
#undef LDB
#undef MMA
}

__device__ __forceinline__ f32x4 mma_lds(const bfr* A, int lda, const bfr* B, int ldb, int ksteps, f32x4 acc, int fr, int fq) {
  for (int ks = 0; ks < ksteps; ++ks) {
    bf16x8 a = *(const bf16x8*)(A + fr * lda + ks * 32 + fq * 8);
    bf16x8 b = *(const bf16x8*)(B + fr * ldb + ks * 32 + fq * 8);
    acc = __builtin_amdgcn_mfma_f32_16x16x32_bf16(a, b, acc, 0, 0, 0);
  }
  return acc;
}

__device__ void ssd_unit(const KP& p, int l, int s, int h, int ph) {
  extern __shared__ __attribute__((aligned(16))) unsigned char smem[];
  int tid_ = threadIdx.x; asm volatile("" : "+v"(tid_));
  const int tid = tid_, w = tid >> 6, lane = tid & 63, fr = lane & 15, fq = lane >> 4;
  bfr* Cs = (bfr*)smem;
  bfr* Bs = Cs + 64 * 136;
  bfr* BTs = Bs + 64 * 136;
  bfr* xTs = BTs + 128 * 72;
  bfr* xwTs = xTs + 32 * 72;
  bfr* Gs = xwTs + 32 * 72;
  bfr* Sbs = Gs + 64 * 72;
  bfr* raw = Sbs + 32 * 136;
  float* dtv = (float*)(raw + 67 * 288);
  float* cumv = dtv + 64;

  const bool prompt = s < 8;
  const int sb = s & 7;
  const int row0 = prompt ? s * PROW : SROW0 + sb * 64;
  const int nch = prompt ? 65 : 1, len = prompt ? PLEN : 64;
  const int g = h >> 2;
  const bfr* proj = (const bfr*)(p.ws + OFF_U);
  const float* dtbuf = (const float*)(p.ws + OFF_DT);
  bfr* mix = (bfr*)(p.ws + OFF_MIX);
  const float Ah = -__expf(p.in[15][l * 8 + h]);
  const float dtbias = p.in[14][l * 8 + h];
  const float Dh = p.in[16][l * 8 + h];
  const float* convw = p.in[12] + (size_t)l * 4 * 1024;
  const float* convb = p.in[13] + (size_t)l * 1024;

  f32x4 Sacc[2];
#pragma unroll
  for (int pt = 0; pt < 2; ++pt)
#pragma unroll
    for (int j = 0; j < 4; ++j) {
      int pp = pt * 16 + fq * 4 + j, n = 16 * w + fr;
      float v = 0.f;
      if (!prompt) v = p.in[3][((((size_t)l * 8 + sb) * 8 + h) * 64 + ph * 32 + pp) * 128 + n];
      Sacc[pt][j] = v;
      Sbs[pp * 136 + n] = f2bf(v);
    }

  for (int c = 0; c < nch; ++c) {
    const int r0 = row0 + c * 64;
    for (int v = tid; v < 67 * 36; v += 512) {
      int rr = v / 36, q = v % 36, col, cc;
      if (q < 4) { col = 512 + h * 64 + ph * 32 + q * 8; cc = q * 8; }
      else if (q < 20) { col = 1024 + g * 128 + (q - 4) * 8; cc = 32 + (q - 4) * 8; }
      else { col = 1280 + g * 128 + (q - 20) * 8; cc = 160 + (q - 20) * 8; }
      u32x4 val;
      if (c == 0 && rr < 3) {
        if (prompt) val = u32x4{0u, 0u, 0u, 0u};
        else {
          const float* sp = p.in[2] + (((size_t)l * 8 + sb) * 3 + rr) * 1024 + (col - 512);
          val[0] = pack2(sp[0], sp[1]); val[1] = pack2(sp[2], sp[3]); val[2] = pack2(sp[4], sp[5]); val[3] = pack2(sp[6], sp[7]);
        }
      } else val = *(const u32x4*)(proj + (size_t)(r0 - 3 + rr) * NIN + col);
      *(u32x4*)(raw + rr * 288 + cc) = val;
    }
    if (tid < 64) {
      int i = tid;
      float x = dtbuf[(size_t)(r0 + i) * 8 + h] + dtbias;
      float dt = (x > 20.f) ? x : log1pf(__expf(x));
      if (c * 64 + i >= len) dt = 0.f;
      float cum = dt * Ah;
#pragma unroll
      for (int o = 1; o < 64; o <<= 1) { float t = __shfl_up(cum, o); if (i >= o) cum += t; }
      dtv[i] = dt; cumv[i] = cum;
    }
    __syncthreads();
    {
      const float cl = cumv[63];
      for (int it = 0; it < 36; ++it) {
        int e = tid + 512 * it, i = e / 288, cc = e % 288;
        int ch = (cc < 32) ? (h * 64 + ph * 32 + cc) : ((cc < 160) ? (512 + g * 128 + cc - 32) : (768 + g * 128 + cc - 160));
        float val = convb[ch];
#pragma unroll
        for (int k = 0; k < 4; ++k) val += bf2f(raw[(i + k) * 288 + cc]) * convw[k * 1024 + ch];
        val = siluf(val);
        if (cc < 32) {
          xTs[cc * 72 + i] = f2bf(val);
          xwTs[cc * 72 + i] = f2bf(val * dtv[i] * __expf(cl - cumv[i]));
        } else if (cc < 160) {
          bfr b = f2bf(val);
          Bs[i * 136 + (cc - 32)] = b; BTs[(cc - 32) * 72 + i] = b;
        } else Cs[i * 136 + (cc - 160)] = f2bf(val);
      }
    }
    __syncthreads();
#pragma unroll
    for (int q = 0; q < 2; ++q) {
      int t = w * 2 + q, ti = t >> 2, tj = t & 3;
      f32x4 a = f32x4{0.f, 0.f, 0.f, 0.f};
      if (tj <= ti) a = mma_lds(Cs + ti * 16 * 136, 136, Bs + tj * 16 * 136, 136, 4, a, fr, fq);
      int jx = tj * 16 + fr;
      float cj = cumv[jx], dj = dtv[jx];
#pragma unroll
      for (int j = 0; j < 4; ++j) {
        int i = ti * 16 + fq * 4 + j;
        float gv = (tj <= ti && jx <= i) ? a[j] * __expf(cumv[i] - cj) * dj : 0.f;
        Gs[i * 72 + jx] = f2bf(gv);
      }
    }
    __syncthreads();
    {
      int ti = w >> 1, tp = w & 1;
      f32x4 a1 = f32x4{0.f, 0.f, 0.f, 0.f}, a2 = f32x4{0.f, 0.f, 0.f, 0.f};
      a1 = mma_lds(Gs + ti * 16 * 72, 72, xTs + tp * 16 * 72, 72, 2, a1, fr, fq);
      a2 = mma_lds(Cs + ti * 16 * 136, 136, Sbs + tp * 16 * 136, 136, 4, a2, fr, fq);
      int pp = tp * 16 + fr, zc = h * 64 + ph * 32 + pp;
#pragma unroll
      for (int j = 0; j < 4; ++j) {
        int i = ti * 16 + fq * 4 + j, row = r0 + i;
        float y = a1[j] + __expf(cumv[i]) * a2[j] + Dh * bf2f(xTs[pp * 72 + i]);
        float zv = bf2f(proj[(size_t)row * NIN + zc]);
        float yz = y * siluf(zv);
        if (c * 64 + i >= len) yz = 0.f;
        mix[(size_t)row * DM + zc] = f2bf(yz);
      }
    }
    __syncthreads();
    {
      float dec = __expf(cumv[63]);
#pragma unroll
      for (int pt = 0; pt < 2; ++pt) {
        f32x4 a = Sacc[pt];
        a[0] *= dec; a[1] *= dec; a[2] *= dec; a[3] *= dec;
        a = mma_lds(xwTs + pt * 16 * 72, 72, BTs + w * 16 * 72, 72, 2, a, fr, fq);
        Sacc[pt] = a;
#pragma unroll
        for (int j = 0; j < 4; ++j) Sbs[(pt * 16 + fq * 4 + j) * 136 + 16 * w + fr] = f2bf(a[j]);
      }
    }
    __syncthreads();
  }
  float* so = p.out + (prompt ? O_SP : O_SS) + (((size_t)l * 8 + sb) * 8 + h) * 64 * 128;
#pragma unroll
  for (int pt = 0; pt < 2; ++pt)
#pragma unroll
    for (int j = 0; j < 4; ++j) so[(size_t)(ph * 32 + pt * 16 + fq * 4 + j) * 128 + 16 * w + fr] = Sacc[pt][j];
}

__device__ void gla_unit(const KP& p, int l, int s, int h, int vq) {
  extern __shared__ __attribute__((aligned(16))) unsigned char smem[];
  int tid_ = threadIdx.x; asm volatile("" : "+v"(tid_));
  const int tid = tid_, w = tid >> 6, lane = tid & 63, fr = lane & 15, fq = lane >> 4;
  bfr* qes = (bfr*)smem;
  bfr* kes = qes + 32 * 136;
  bfr* kdTs = kes + 32 * 136;
  bfr* vTs = kdTs + 128 * 40;
  bfr* atts = vTs + 32 * 40;
  bfr* STs = atts + 32 * 40;
  float* cumL = (float*)(STs + 32 * 136);

  const bool prompt = s < 8;
  const int sb = s & 7;
  const int row0 = prompt ? s * PROW : SROW0 + sb * 64;
  const int nst = prompt ? 130 : 2, len = prompt ? PLEN : 64;
  const bfr* proj = (const bfr*)(p.ws + OFF_U);
  bfr* mix = (bfr*)(p.ws + OFF_MIX);
  const int kk_ = tid & 127;
  float lb = 0.f;
  if (l == 1) {
    float d = p.in[18][512 + h * 128 + kk_] - p.in[18][h * 128 + kk_];
    lb = fminf(1.f / (1.f + __expf(-d)), 1.f - 1e-6f);
  }

  f32x4 Sacc[2];
#pragma unroll
  for (int vt = 0; vt < 2; ++vt)
#pragma unroll
    for (int j = 0; j < 4; ++j) {
      int k = 16 * w + fq * 4 + j, v = vt * 16 + fr;
      float x = 0.f;
      if (!prompt) x = p.in[4][((((size_t)l * 8 + sb) * 4 + h) * 128 + k) * 128 + vq * 32 + v];
      Sacc[vt][j] = x;
      STs[v * 136 + k] = f2bf(x);
    }

  for (int st = 0; st < nst; ++st) {
    const int r0 = row0 + st * 32;
    float qv[8], kv[8];
#pragma unroll
    for (int it = 0; it < 8; ++it) {
      int j = (tid >> 7) + 4 * it, row = r0 + j;
      float hq = bf2f(proj[(size_t)row * NIN + 1536 + h * 128 + kk_]);
      float fx = bf2f(proj[(size_t)row * NIN + 2048 + h * 128 + kk_]);
      qv[it] = siluf(hq);
      float kkv = (1.f - lb) / (1.f + __expf(fx));
      float f = lb + (1.f - lb) / (1.f + __expf(-fx));
      float lf = (kkv < 0.5f) ? log1pf(-kkv) : __logf(fmaxf(f, 1e-30f));
      if (st * 32 + j >= len) { kkv = 0.f; lf = 0.f; }
      kv[it] = kkv;
      cumL[j * 128 + kk_] = lf;
    }
#pragma unroll
    for (int it = 0; it < 2; ++it) {
      int e = tid + 512 * it, j = e >> 5, v = e & 31;
      vTs[v * 40 + j] = proj[(size_t)(r0 + j) * NIN + 2560 + h * 128 + vq * 32 + v];
    }
    __syncthreads();
    if (tid < 128) {
      float run = 0.f;
      for (int j = 0; j < 32; ++j) { run += cumL[j * 128 + tid]; cumL[j * 128 + tid] = run; }
    }
    __syncthreads();
    {
      float cl = cumL[31 * 128 + kk_];
#pragma unroll
      for (int it = 0; it < 8; ++it) {
        int j = (tid >> 7) + 4 * it;
        float c = cumL[j * 128 + kk_];
        qes[j * 136 + kk_] = f2bf(qv[it] * __expf(c));
        kes[j * 136 + kk_] = f2bf(kv[it] * __expf(-c));
        kdTs[kk_ * 40 + j] = f2bf(kv[it] * __expf(cl - c));
      }
    }
    __syncthreads();
    if (w < 4) {
      int ti = w >> 1, tj = w & 1;
      f32x4 a = f32x4{0.f, 0.f, 0.f, 0.f};
      if (tj <= ti) a = mma_lds(qes + ti * 16 * 136, 136, kes + tj * 16 * 136, 136, 4, a, fr, fq);
      int jx = tj * 16 + fr;
#pragma unroll
      for (int j = 0; j < 4; ++j) {
        int i = ti * 16 + fq * 4 + j;
        atts[i * 40 + jx] = f2bf((tj <= ti && jx <= i) ? a[j] : 0.f);
      }
    }
    __syncthreads();
    if (w < 4) {
      int ti = w >> 1, tv = w & 1;
      f32x4 a = f32x4{0.f, 0.f, 0.f, 0.f};
      a = mma_lds(atts + ti * 16 * 40, 40, vTs + tv * 16 * 40, 40, 1, a, fr, fq);
      a = mma_lds(qes + ti * 16 * 136, 136, STs + tv * 16 * 136, 136, 4, a, fr, fq);
#pragma unroll
      for (int j = 0; j < 4; ++j) {
        int i = ti * 16 + fq * 4 + j, row = r0 + i;
        float o = (st * 32 + i >= len) ? 0.f : a[j];
        mix[(size_t)row * DM + 512 + h * 128 + vq * 32 + tv * 16 + fr] = f2bf(o);
      }
    }
    __syncthreads();
    {
      float dec[4];
#pragma unroll
      for (int j = 0; j < 4; ++j) dec[j] = __expf(cumL[31 * 128 + 16 * w + fq * 4 + j]);
#pragma unroll
      for (int vt = 0; vt < 2; ++vt) {
        f32x4 a = Sacc[vt];
#pragma unroll
        for (int j = 0; j < 4; ++j) a[j] *= dec[j];
        a = mma_lds(kdTs + w * 16 * 40, 40, vTs + vt * 16 * 40, 40, 1, a, fr, fq);
        Sacc[vt] = a;
#pragma unroll
        for (int j = 0; j < 4; ++j) STs[(vt * 16 + fr) * 136 + 16 * w + fq * 4 + j] = f2bf(a[j]);
      }
    }
    __syncthreads();
  }
  float* so = p.out + (prompt ? O_HP : O_HS) + (((size_t)l * 8 + sb) * 4 + h) * 128 * 128;
#pragma unroll
  for (int vt = 0; vt < 2; ++vt)
#pragma unroll
    for (int j = 0; j < 4; ++j) so[(size_t)(16 * w + fq * 4 + j) * 128 + vq * 32 + vt * 16 + fr] = Sacc[vt][j];
}

__device__ void phase_scan(const KP& p, int l) {
  for (int u = blockIdx.x; u < 512; u += gridDim.x) {
    int uu = u & 255, soff = (u >= 256) ? 8 : 0;
    if (uu < 128) ssd_unit(p, l, soff + (uu >> 4), (uu & 15) >> 1, uu & 1);
    else { int v = uu - 128; gla_unit(p, l, soff + (v >> 4), (v & 15) >> 2, v & 3); }
    __syncthreads();
  }
}

__device__ void run_phase(const KP& p, int ph) {
  const bfr* W = (const bfr*)(p.ws + OFF_W);
  const bfr* hb = (const bfr*)(p.ws + OFF_HB);
  const bfr* U = (const bfr*)(p.ws + OFF_U);
  const bfr* mix = (const bfr*)(p.ws + OFF_MIX);
  if (ph == 0) { phase_prep(p); phase_init(p); return; }
  int l = (ph - 1) / 11, q = (ph - 1) % 11;
  const bfr* Wl = W + (size_t)l * W_LAYER;
  if (q == 2 || q == 7 || (q == 10 && l == 0)) { phase_stat(p); return; }
  if (q == 10) { phase_final(p); return; }
  if (q == 4) { phase_scan(p, l); return; }
  if (q == 5) { phase_mixnorm(p, l); return; }
  if (q == 0) gemm_phase<1, NGU, DM>(p, l, hb, Wl + W_GUA);
  else if (q == 1) gemm_phase<2, DM, DFF>(p, l, U, Wl + W_DA);
  else if (q == 3) gemm_phase<3, NINP, DM>(p, l, hb, Wl + W_IN);
  else if (q == 6) gemm_phase<2, DM, DM>(p, l, mix, Wl + W_OUT);
  else if (q == 8) gemm_phase<1, NGU, DM>(p, l, hb, Wl + W_GUB);
  else gemm_phase<2, DM, DFF>(p, l, U, Wl + W_DB);
}

__global__ void __launch_bounds__(512, 2) hymba_fwd(KP p) {
  for (int ph = p.ph_lo; ph < p.ph_hi; ++ph) {
    run_phase(p, ph);
    if (ph + 1 < p.ph_hi) cg::this_grid().sync();
  }
}

extern "C" void kernel_launch(void* const* d_in, const int* in_sizes, int n_in, void* d_out, int out_size,
                              void* d_ws, size_t ws_size, hipStream_t stream) {
  static int grid = 0;
  if (!grid) {
    int dev = 0, cus = 0, per_cu = 0;
    hipGetDevice(&dev);
    hipDeviceGetAttribute(&cus, hipDeviceAttributeMultiprocessorCount, dev);
    hipFuncSetAttribute((const void*)hymba_fwd, hipFuncAttributeMaxDynamicSharedMemorySize, LDS_BYTES);
    hipOccupancyMaxActiveBlocksPerMultiprocessor(&per_cu, (const void*)hymba_fwd, 512, LDS_BYTES);
    if (per_cu < 1) per_cu = 1;
    grid = cus * per_cu;
    if (grid > 256) grid = 256;
  }
  KP p{};
  for (int i = 0; i < 26; ++i) p.in[i] = (const float*)d_in[i];
  p.out = (float*)d_out; p.ws = (unsigned char*)d_ws;
#if SINGLE_LAUNCH
  p.ph_lo = 0; p.ph_hi = NPHASE;
  void* args[] = {&p};
  hipError_t e = hipLaunchCooperativeKernel((const void*)hymba_fwd, dim3(grid), dim3(512), args, LDS_BYTES, stream);
  if (e != hipSuccess) fprintf(stderr, "cooperative launch failed: %s (grid %d)\n", hipGetErrorString(e), grid);
#else
  for (int ph = 0; ph < NPHASE; ++ph) {
    p.ph_lo = ph; p.ph_hi = ph + 1;
    hipLaunchKernelGGL(hymba_fwd, dim3(grid), dim3(512), LDS_BYTES, stream, p);
  }
#endif
}
```

```cpp
#include <hip/hip_runtime.h>
#include <hip/hip_bf16.h>
#include <hip/hip_cooperative_groups.h>
#include <cstdio>
namespace cg = cooperative_groups;

#ifndef SINGLE_LAUNCH
#define SINGLE_LAUNCH 1
#endif

typedef unsigned short bfr;
using bf16x8 = __attribute__((ext_vector_type(8))) short;
using f32x4  = __attribute__((ext_vector_type(4))) float;
using u32x4  = __attribute__((ext_vector_type(4))) unsigned;

constexpr int T_ROWS = 33792;
constexpr int PROW = 4160, PLEN = 4112, SROW0 = 33280;
constexpr int DM = 1024, DFF = 2816, NGU = 5632, NIN = 3584, NINP = 3840;
constexpr float EPSF = 1e-6f;
constexpr size_t OFF_HB = 0;
constexpr size_t OFF_RS = 69206016;
constexpr size_t OFF_DT = 69341184;
constexpr size_t OFF_U = 70422528;
constexpr size_t OFF_MIX = 312643584;
constexpr size_t OFF_W = 381849600;
constexpr size_t W_GUA = 0, W_DA = 5767168, W_IN = 8650752, W_OUT = 12582912, W_GUB = 13631488, W_DB = 19398656, W_LAYER = 22282240;
constexpr size_t O_YP = 0, O_YS = 33554432, O_CP = 34078720, O_SP = 34127872, O_HP = 35176448, O_CS = 36225024, O_SS = 36274176, O_HS = 37322752;
constexpr size_t OFF_TAILS = 470978560;
constexpr size_t OFF_DEC = 474222592;
constexpr size_t OFF_BAR = 476385280;
constexpr int LDS_BYTES = 131072 + 16;
constexpr int NPHASE = 25;

struct KP {
  const float* in[26];
  float* out;
  unsigned char* ws;
  int ph_lo, ph_hi;
  int bid, nblk;
};

typedef __bf16 bf16v2_t __attribute__((ext_vector_type(2)));
typedef float f32v2_t __attribute__((ext_vector_type(2)));
__device__ __forceinline__ unsigned pack2(float a, float b) { f32v2_t v = {a, b}; bf16v2_t r = __builtin_convertvector(v, bf16v2_t); return __builtin_bit_cast(unsigned, r); }
__device__ __forceinline__ bfr f2bf(float f) { return (bfr)(pack2(f, f) & 0xffffu); }
__device__ __forceinline__ float bf2f(bfr b) { return __uint_as_float(((unsigned)b) << 16); }
__device__ __forceinline__ float siluf(float x) { return __fdividef(x, 1.f + __expf(-x)); }

struct PrepMeta { int l, K, n0, k0; size_t woff; };
__device__ __forceinline__ void prep_load(const KP& p, int job, int tid, float (&v)[8], PrepMeta& m) {
  int l = job / 5440, j = job % 5440;
  int mat, nt, kt, K; size_t woff;
  const float *s0, *s1, *sc; int ldn; float cs;
  if (j < 1408) { mat = 0; nt = j / 16; kt = j % 16; K = DM; woff = W_GUA; s0 = p.in[7] + (size_t)l * DM * DFF; s1 = p.in[8] + (size_t)l * DM * DFF; sc = p.in[6] + l * DM; ldn = DFF; cs = 1.f; }
  else if (j < 2112) { j -= 1408; mat = 1; nt = j / 44; kt = j % 44; K = DFF; woff = W_DA; s0 = s1 = p.in[9] + (size_t)l * DFF * DM; sc = nullptr; ldn = DM; cs = 0.5f; }
  else if (j < 3072) { j -= 2112; mat = 2; nt = j / 16; kt = j % 16; K = DM; woff = W_IN; s0 = s1 = p.in[11] + (size_t)l * DM * 3592; sc = p.in[10] + l * DM; ldn = 3592; cs = 1.f; }
  else if (j < 3328) { j -= 3072; mat = 3; nt = j / 16; kt = j % 16; K = DM; woff = W_OUT; s0 = s1 = p.in[20] + (size_t)l * DM * DM; sc = nullptr; ldn = DM; cs = 1.f; }
  else if (j < 4736) { j -= 3328; mat = 0; nt = j / 16; kt = j % 16; K = DM; woff = W_GUB; s0 = p.in[22] + (size_t)l * DM * DFF; s1 = p.in[23] + (size_t)l * DM * DFF; sc = p.in[21] + l * DM; ldn = DFF; cs = 1.f; }
  else { j -= 4736; mat = 1; nt = j / 44; kt = j % 44; K = DFF; woff = W_DB; s0 = s1 = p.in[24] + (size_t)l * DFF * DM; sc = nullptr; ldn = DM; cs = 0.5f; }
  const int n0 = nt * 64, k0 = kt * 64;
  m.l = l; m.K = K; m.n0 = n0; m.k0 = k0; m.woff = woff;
#pragma unroll
  for (int it = 0; it < 8; ++it) {
    int e = tid + 512 * it, kk = e >> 6, nn = e & 63;
    int k = k0 + kk, n = n0 + nn, c; bool ok = true; const float* sp = s0;
    const int nl = n & 255, bj = nl >> 7, wc_ = (nl >> 5) & 3, ns = (nl >> 4) & 1, r = nl & 15;
    if (mat == 0) { c = (n >> 8) * 128 + wc_ * 32 + (r >> 2) * 8 + bj * 4 + (r & 3); if (ns) sp = s1; }
    else {
      c = (n & ~255) + bj * 128 + wc_ * 32 + (r >> 2) * 8 + ns * 4 + (r & 3);
      if (mat == 2) { if (c < 1536) c = c; else if (c < 3584) c = c + 8; else if (c < 3592) c = 1536 + (c - 3584); else { ok = false; c = 0; } }
    }
    float x = sp[(size_t)k * ldn + c] * cs;
    if (sc) x *= sc[k];
    v[it] = ok ? x : 0.f;
  }
}
__device__ __forceinline__ void prep_tile_out(bfr* W, const float* tile, int tid, const float (&v)[8], const PrepMeta& m) {
#pragma unroll
  for (int it = 0; it < 8; ++it) { int e = tid + 512 * it; ((float*)tile)[(e >> 6) * 65 + (e & 63)] = v[it]; }
}
__device__ void phase_prep(const KP& p, int job_lo, int job_hi, int first_blk) {
  extern __shared__ __attribute__((aligned(16))) unsigned char smem[];
  int tid = threadIdx.x; asm volatile("" : "+v"(tid));
  bfr* W = (bfr*)(p.ws + OFF_W);
  const int total = (p.bid < first_blk) ? 0 : job_hi, stride = p.nblk - first_blk;
  float va[8], vb[8]; PrepMeta ma, mb;
  const int j0 = job_lo + (p.bid - first_blk);
  if (j0 < total) prep_load(p, j0, tid, va, ma);
  if (j0 + stride < total) prep_load(p, j0 + stride, tid, vb, mb);
  int buf = 0;
  for (int job = j0; job < total; job += 2 * stride) {
#pragma unroll
    for (int half = 0; half < 2; ++half) {
      const int jb = job + half * stride;
      if (jb < total) {
        float* tile = (float*)smem + buf * (64 * 65);
        PrepMeta mc = half ? mb : ma;
        if (half == 0) prep_tile_out(W, tile, tid, va, ma); else prep_tile_out(W, tile, tid, vb, mb);
        __syncthreads();
        if (jb + 2 * stride < total) { if (half == 0) prep_load(p, jb + 2 * stride, tid, va, ma); else prep_load(p, jb + 2 * stride, tid, vb, mb); }
        {
          int nn = tid >> 3, seg = tid & 7;
          u32x4 v;
          v[0] = pack2(tile[(seg * 8 + 0) * 65 + nn], tile[(seg * 8 + 1) * 65 + nn]);
          v[1] = pack2(tile[(seg * 8 + 2) * 65 + nn], tile[(seg * 8 + 3) * 65 + nn]);
          v[2] = pack2(tile[(seg * 8 + 4) * 65 + nn], tile[(seg * 8 + 5) * 65 + nn]);
          v[3] = pack2(tile[(seg * 8 + 6) * 65 + nn], tile[(seg * 8 + 7) * 65 + nn]);
          *(u32x4*)(W + (size_t)mc.l * W_LAYER + mc.woff + (size_t)(mc.n0 + nn) * mc.K + mc.k0 + seg * 8) = v;
        }
        buf ^= 1;
      }
    }
  }
  __syncthreads();
}

__device__ __forceinline__ float wave_sum(float v) {
#pragma unroll
  for (int o = 32; o >= 1; o >>= 1) v += __shfl_xor(v, o);
  return v;
}

__device__ void phase_init(const KP& p) {
  int tid_ = threadIdx.x; asm volatile("" : "+v"(tid_));
  const int lane = tid_ & 63, w = tid_ >> 6;
  bfr* hb = (bfr*)(p.ws + OFF_HB);
  float* rs = (float*)(p.ws + OFF_RS);
  for (int row = p.bid * 8 + w; row < T_ROWS; row += p.nblk * 8) {
    const float* src = nullptr;
    if (row < SROW0) {
      int s = row / PROW, pos = row % PROW;
      if (pos < 16) src = p.in[5] + (size_t)pos * DM;
      else if (pos < PLEN) src = p.in[0] + ((size_t)s * 4096 + (pos - 16)) * DM;
    } else src = p.in[1] + (size_t)(row - SROW0) * DM;
    float ss = 0.f;
#pragma unroll
    for (int i = 0; i < 4; ++i) {
      int c = 4 * (lane + 64 * i);
      float4 v = src ? *(const float4*)(src + c) : make_float4(0.f, 0.f, 0.f, 0.f);
      bfr b0 = f2bf(v.x), b1 = f2bf(v.y), b2 = f2bf(v.z), b3 = f2bf(v.w);
      float r0 = bf2f(b0), r1 = bf2f(b1), r2 = bf2f(b2), r3 = bf2f(b3);
      ss += r0 * r0 + r1 * r1 + r2 * r2 + r3 * r3;
      uint2 o; o.x = (unsigned)b0 | ((unsigned)b1 << 16); o.y = (unsigned)b2 | ((unsigned)b3 << 16);
      *(uint2*)(hb + (size_t)row * DM + c) = o;
    }
    ss = wave_sum(ss);
    if (lane == 0) rs[row] = rsqrtf(ss * (1.f / DM) + EPSF);
  }
}

__device__ void phase_stat(const KP& p) {
  int tid_ = threadIdx.x; asm volatile("" : "+v"(tid_));
  const int lane = tid_ & 63, w = tid_ >> 6;
  const bfr* hb = (const bfr*)(p.ws + OFF_HB);
  float* rs = (float*)(p.ws + OFF_RS);
  for (int row = p.bid * 8 + w; row < T_ROWS; row += p.nblk * 8) {
    float ss = 0.f;
#pragma unroll
    for (int i = 0; i < 2; ++i) {
      u32x4 v = *(const u32x4*)(hb + (size_t)row * DM + lane * 8 + 512 * i);
#pragma unroll
      for (int e = 0; e < 4; ++e) {
        float a = __uint_as_float(v[e] << 16), b = __uint_as_float(v[e] & 0xffff0000u);
        ss += a * a + b * b;
      }
    }
    ss = wave_sum(ss);
    if (lane == 0) rs[row] = rsqrtf(ss * (1.f / DM) + EPSF);
  }
}

__device__ void phase_final(const KP& p) {
  int tid_ = threadIdx.x; asm volatile("" : "+v"(tid_));
  const int lane = tid_ & 63, w = tid_ >> 6;
  const bfr* hb = (const bfr*)(p.ws + OFF_HB);
  const float* lw = p.in[25];
  for (int row = p.bid * 8 + w; row < T_ROWS; row += p.nblk * 8) {
    float* dst;
    if (row < SROW0) {
      int s = row / PROW, pos = row % PROW;
      if (pos < 16 || pos >= PLEN) continue;
      dst = p.out + O_YP + ((size_t)s * 4096 + (pos - 16)) * DM;
    } else dst = p.out + O_YS + (size_t)(row - SROW0) * DM;
    float x[16];
    float ss = 0.f;
#pragma unroll
    for (int i = 0; i < 2; ++i) {
      u32x4 v = *(const u32x4*)(hb + (size_t)row * DM + lane * 8 + 512 * i);
#pragma unroll
      for (int e = 0; e < 4; ++e) {
        float a = __uint_as_float(v[e] << 16), b = __uint_as_float(v[e] & 0xffff0000u);
        x[i * 8 + e * 2] = a; x[i * 8 + e * 2 + 1] = b;
        ss += a * a + b * b;
      }
    }
    ss = wave_sum(ss);
    float r = rsqrtf(ss * (1.f / DM) + EPSF);
#pragma unroll
    for (int i = 0; i < 2; ++i) {
      int c = lane * 8 + 512 * i;
      float4 w0 = *(const float4*)(lw + c), w1 = *(const float4*)(lw + c + 4);
      float4 o0 = make_float4(x[i * 8 + 0] * r * w0.x, x[i * 8 + 1] * r * w0.y, x[i * 8 + 2] * r * w0.z, x[i * 8 + 3] * r * w0.w);
      float4 o1 = make_float4(x[i * 8 + 4] * r * w1.x, x[i * 8 + 5] * r * w1.y, x[i * 8 + 6] * r * w1.z, x[i * 8 + 7] * r * w1.w);
      *(float4*)(dst + c) = o0; *(float4*)(dst + c + 4) = o1;
    }
  }
}

__device__ void phase_mixnorm(const KP& p, int l) {
  int tid_ = threadIdx.x; asm volatile("" : "+v"(tid_));
  const int lane = tid_ & 63, w = tid_ >> 6;
  bfr* mix = (bfr*)(p.ws + OFF_MIX);
  const bfr* proj = (const bfr*)(p.ws + OFF_U);
  for (int row = p.bid * 8 + w; row < T_ROWS; row += p.nblk * 8) {
    bfr* mp = mix + (size_t)row * DM + lane * 16;
    u32x4 v0 = *(const u32x4*)mp, v1 = *(const u32x4*)(mp + 8);
    float x[16];
#pragma unroll
    for (int e = 0; e < 4; ++e) {
      x[e * 2] = __uint_as_float(v0[e] << 16); x[e * 2 + 1] = __uint_as_float(v0[e] & 0xffff0000u);
      x[8 + e * 2] = __uint_as_float(v1[e] << 16); x[8 + e * 2 + 1] = __uint_as_float(v1[e] & 0xffff0000u);
    }
    float ss = 0.f;
#pragma unroll
    for (int e = 0; e < 16; ++e) ss += x[e] * x[e];
    ss += __shfl_xor(ss, 1); ss += __shfl_xor(ss, 2); ss += __shfl_xor(ss, 4);
    float s8 = __shfl_xor(ss, 8);
    float r;
    if (lane < 32) r = rsqrtf((ss + s8) * (1.f / 256.f) + EPSF);
    else r = rsqrtf(ss * (1.f / 128.f) + EPSF);
    float o[16];
    if (lane < 32) {
      const float* nw = p.in[17] + l * 512 + lane * 16;
#pragma unroll
      for (int e = 0; e < 16; ++e) o[e] = x[e] * r * nw[e];
    } else {
      int cg0 = (lane - 32) * 16;
      const float* nw = p.in[19] + l * 512 + cg0;
      const bfr* gp = proj + (size_t)row * NIN + 3072 + cg0;
      u32x4 g0 = *(const u32x4*)gp, g1 = *(const u32x4*)(gp + 8);
      float g[16];
#pragma unroll
      for (int e = 0; e < 4; ++e) {
        g[e * 2] = __uint_as_float(g0[e] << 16); g[e * 2 + 1] = __uint_as_float(g0[e] & 0xffff0000u);
        g[8 + e * 2] = __uint_as_float(g1[e] << 16); g[8 + e * 2 + 1] = __uint_as_float(g1[e] & 0xffff0000u);
      }
#pragma unroll
      for (int e = 0; e < 16; ++e) o[e] = x[e] * r * nw[e] * siluf(g[e]);
    }
    u32x4 w0, w1;
#pragma unroll
    for (int e = 0; e < 4; ++e) { w0[e] = pack2(o[e * 2], o[e * 2 + 1]); w1[e] = pack2(o[8 + e * 2], o[8 + e * 2 + 1]); }
    *(u32x4*)mp = w0; *(u32x4*)(mp + 8) = w1;
  }
}

constexpr int BM = 256, BK = 64, HALF = 128, NXCD = 8, WGM = 8, HT = HALF * BK;

__device__ __forceinline__ int lds_byte(int r, int c) {
  int st = (r >> 4) * 2 + (c >> 5), rr = r & 15, cc = c & 31, ob = rr * 64 + cc * 2;
  return st * 1024 + (ob ^ (((ob >> 9) & 1) << 5));
}
__device__ __forceinline__ void stage_rc(int b, int& R, int& C) {
  int st = b / 1024, sb = b % 1024, swz = sb ^ (((sb >> 9) & 1) << 5);
  R = (st >> 1) * 16 + swz / 64; C = (st & 1) * 32 + (swz % 64) / 2;
}

template <int EPI, int N, int K>
__device__ __forceinline__ void gemm_phase(const KP& p, int l, const bfr* A, const bfr* Bt) {
  extern __shared__ __attribute__((aligned(16))) unsigned char smem[];
  bfr* shm = (bfr*)smem;
#define SA(b, h) (shm + ((b) * 2 + (h)) * HT)
#define SB(b, h) (shm + (4 + (b) * 2 + (h)) * HT)
#define STAGE_B(P, BASE, br, kt) do { const char* _gb = (const char*)((BASE) + (long)(br) * K + (long)(kt) * BK); \
    unsigned _o0 = so0, _o1 = so1; asm volatile("" : "+v"(_o0), "+v"(_o1)); \
    __builtin_amdgcn_global_load_lds((const unsigned*)(_gb + _o0), (unsigned*)((char*)(P) + tid * 16), 16, 0, 0); \
    __builtin_amdgcn_global_load_lds((const unsigned*)(_gb + _o1), (unsigned*)((char*)(P) + tid * 16 + 8192), 16, 0, 0); } while (0)
#define STAGE_A(P, BASE, br, kt) STAGE_B(P, BASE, br, kt)
#define LDA(dst, b, h) for (int m = 0; m < 4; ++m) for (int k = 0; k < 2; ++k) \
    dst[m][k] = *reinterpret_cast<const bf16x8*>((char*)SA(b, h) + lds_byte(wr * 64 + m * 16 + fr, k * 32 + fq * 8))
#define LDB(dst, b, h) for (int n = 0; n < 2; ++n) for (int k = 0; k < 2; ++k) \
    dst[n][k] = *reinterpret_cast<const bf16x8*>((char*)SB(b, h) + lds_byte(wc * 32 + n * 16 + fr, k * 32 + fq * 8))
#define MMA(ai, bj, At, Bq) do { __builtin_amdgcn_s_setprio(1); \
    for (int m = 0; m < 4; ++m) for (int n = 0; n < 2; ++n) for (int k = 0; k < 2; ++k) \
      acc[ai][bj][m][n] = __builtin_amdgcn_mfma_f32_16x16x32_bf16(Bq[n][k], At[m][k], acc[ai][bj][m][n], 0, 0, 0); \
    __builtin_amdgcn_s_setprio(0); } while (0)
#define WAIT_V(n) asm volatile("s_waitcnt vmcnt(" #n ")" ::: "memory")
#define WAIT_L(n) asm volatile("s_waitcnt lgkmcnt(" #n ")" ::: "memory")
#define BAR __builtin_amdgcn_s_barrier()
#define SCHED __builtin_amdgcn_sched_barrier(0)

  constexpr int TM = 256, HM = 128;
  const int nM = T_ROWS / TM, nN = N / BM, nwg = nM * nN;
  int tid = threadIdx.x; asm volatile("" : "+v"(tid));
  const int wid = tid >> 6, lane = tid & 63, wr = wid >> 2, wc = wid & 3, fr = lane & 15, fq = lane >> 4;
  const int nt = K / BK;
  unsigned so0, so1;
  { int _r, _c; stage_rc(tid * 16, _r, _c); so0 = (unsigned)(_r * K + _c) * 2u; stage_rc(tid * 16 + 8192, _r, _c); so1 = (unsigned)(_r * K + _c) * 2u; }
#define TILE_COORDS(LT, BROW, BCOL, PN) do { int wgid = (LT); \
    { int q = nwg / NXCD, r = nwg % NXCD, xcd = wgid % NXCD, off = wgid / NXCD; \
      wgid = (xcd < r ? xcd * (q + 1) : r * (q + 1) + (xcd - r) * q) + off; } \
    int nig = WGM * nN, gid = wgid / nig, fm = gid * WGM, gsz = min(nM - fm, WGM); \
    int pm_ = fm + ((wgid % nig) % gsz); PN = (wgid % nig) / gsz; BROW = pm_ * TM; BCOL = PN * BM; } while (0)
  int brow = 0, bcol = 0, pn = 0;
  if (p.bid < nwg) {
    TILE_COORDS(p.bid, brow, bcol, pn);
    STAGE_B(SB(0, 0), Bt, bcol, 0); STAGE_A(SA(0, 0), A, brow, 0);
    STAGE_B(SB(0, 1), Bt, bcol + HALF, 0); STAGE_A(SA(0, 1), A, brow + HM, 0);
  }
  for (int Lt = p.bid; Lt < nwg; Lt += p.nblk) {
    f32x4 acc[2][2][4][2];
#pragma unroll
    for (int a = 0; a < 2; ++a)
#pragma unroll
      for (int b = 0; b < 2; ++b)
#pragma unroll
        for (int m = 0; m < 4; ++m)
#pragma unroll
          for (int n = 0; n < 2; ++n) acc[a][b][m][n] = f32x4{0.f, 0.f, 0.f, 0.f};
    bf16x8 At[4][2], B0[2][2], B1[2][2];
    if (wr == 1) BAR;
    WAIT_V(4); BAR;
    STAGE_B(SB(1, 0), Bt, bcol, 1); STAGE_A(SA(1, 0), A, brow, 1); STAGE_B(SB(1, 1), Bt, bcol + HALF, 1);
    WAIT_V(6); BAR;
    for (int t = 0; t < nt - 2; t += 2) {
      LDB(B0, 0, 0); SCHED; LDA(At, 0, 0); STAGE_A(SA(1, 1), A, brow + HM, t + 1);
      WAIT_L(8); BAR; WAIT_L(0); MMA(0, 0, At, B0); BAR; SCHED;
      LDB(B1, 0, 1); STAGE_B(SB(0, 0), Bt, bcol, t + 2);
      BAR; WAIT_L(0); MMA(0, 1, At, B1); BAR;
      LDA(At, 0, 1); STAGE_A(SA(0, 0), A, brow, t + 2);
      BAR; WAIT_L(0); MMA(1, 0, At, B0); BAR; SCHED;
      STAGE_B(SB(0, 1), Bt, bcol + HALF, t + 2);
      WAIT_V(6); BAR; MMA(1, 1, At, B1); BAR;
      LDB(B0, 1, 0); SCHED; LDA(At, 1, 0); STAGE_A(SA(0, 1), A, brow + HM, t + 2);
      WAIT_L(8); BAR; WAIT_L(0); MMA(0, 0, At, B0); BAR; SCHED;
      LDB(B1, 1, 1); STAGE_B(SB(1, 0), Bt, bcol, t + 3);
      BAR; WAIT_L(0); MMA(0, 1, At, B1); BAR;
      LDA(At, 1, 1); STAGE_A(SA(1, 0), A, brow, t + 3);
      BAR; WAIT_L(0); MMA(1, 0, At, B0); BAR; SCHED;
      STAGE_B(SB(1, 1), Bt, bcol + HALF, t + 3);
      WAIT_V(6); BAR; MMA(1, 1, At, B1); BAR;
    }
    { LDB(B0, 0, 0); LDA(At, 0, 0); STAGE_A(SA(1, 1), A, brow + HM, nt - 1);
      BAR; WAIT_L(0); MMA(0, 0, At, B0); BAR;
      LDB(B1, 0, 1); BAR; WAIT_L(0); MMA(0, 1, At, B1); BAR;
      LDA(At, 0, 1); WAIT_V(4); BAR; WAIT_L(0); MMA(1, 0, At, B0); MMA(1, 1, At, B1); BAR; }
    { LDB(B0, 1, 0); LDA(At, 1, 0); WAIT_V(2); BAR; WAIT_L(0); MMA(0, 0, At, B0); BAR;
      LDB(B1, 1, 1); WAIT_V(0); BAR; WAIT_L(0); MMA(0, 1, At, B1); BAR;
      LDA(At, 1, 1); BAR; WAIT_L(0); MMA(1, 0, At, B0); MMA(1, 1, At, B1); BAR; }
    if (wr == 0) BAR;
    const int erow = brow, ecol = bcol, epn = pn;
    if (Lt + p.nblk < nwg) {
      TILE_COORDS(Lt + p.nblk, brow, bcol, pn);
      STAGE_B(SB(0, 0), Bt, bcol, 0); STAGE_A(SA(0, 0), A, brow, 0);
      STAGE_B(SB(0, 1), Bt, bcol + HALF, 0); STAGE_A(SA(0, 1), A, brow + HM, 0);
    }

    const float* rs = (const float*)(p.ws + OFF_RS);
    if (EPI == 1) {
      bfr* act = (bfr*)(p.ws + OFF_U);
#pragma unroll
      for (int ai = 0; ai < 2; ++ai)
#pragma unroll
        for (int m = 0; m < 4; ++m) {
          int row = erow + ai * HM + wr * 64 + m * 16 + fr;
          const float r = rs[row];
          const float nrl = -1.44269504f * r, r2 = r * r;
          u32x4 pk;
#pragma unroll
          for (int bj = 0; bj < 2; ++bj)
#pragma unroll
            for (int jj = 0; jj < 2; ++jj) {
              f32v2_t g2 = {acc[ai][bj][m][0][2 * jj], acc[ai][bj][m][0][2 * jj + 1]};
              f32v2_t u2 = {acc[ai][bj][m][1][2 * jj], acc[ai][bj][m][1][2 * jj + 1]};
              f32v2_t t2 = g2 * nrl;
              f32v2_t e2 = {__builtin_amdgcn_exp2f(t2.x), __builtin_amdgcn_exp2f(t2.y)};
              f32v2_t d2 = e2 + 1.0f;
              f32v2_t rc = {__builtin_amdgcn_rcpf(d2.x), __builtin_amdgcn_rcpf(d2.y)};
              f32v2_t o2 = (g2 * u2) * r2 * rc;
              pk[bj * 2 + jj] = pack2(o2.x, o2.y);
            }
          *(u32x4*)(act + (size_t)row * DFF + (ecol >> 1) + wc * 32 + fq * 8) = pk;
        }
    } else if (EPI == 2) {
      bfr* hb = (bfr*)(p.ws + OFF_HB);
#pragma unroll
      for (int ai = 0; ai < 2; ++ai)
#pragma unroll
        for (int m = 0; m < 4; ++m) {
          int row = erow + ai * HM + wr * 64 + m * 16 + fr;
#pragma unroll
          for (int bj = 0; bj < 2; ++bj) {
            u32x4* hp = (u32x4*)(hb + (size_t)row * DM + ecol + bj * HALF + wc * 32 + fq * 8);
            u32x4 h = *hp, o;
            o[0] = pack2(__uint_as_float(h[0] << 16) + acc[ai][bj][m][0][0], __uint_as_float(h[0] & 0xffff0000u) + acc[ai][bj][m][0][1]);
            o[1] = pack2(__uint_as_float(h[1] << 16) + acc[ai][bj][m][0][2], __uint_as_float(h[1] & 0xffff0000u) + acc[ai][bj][m][0][3]);
            o[2] = pack2(__uint_as_float(h[2] << 16) + acc[ai][bj][m][1][0], __uint_as_float(h[2] & 0xffff0000u) + acc[ai][bj][m][1][1]);
            o[3] = pack2(__uint_as_float(h[3] << 16) + acc[ai][bj][m][1][2], __uint_as_float(h[3] & 0xffff0000u) + acc[ai][bj][m][1][3]);
            *hp = o;
          }
        }
    } else {
      bfr* proj = (bfr*)(p.ws + OFF_U);
      float* dtb = (float*)(p.ws + OFF_DT);
#pragma unroll
      for (int ai = 0; ai < 2; ++ai)
#pragma unroll
        for (int m = 0; m < 4; ++m) {
          int row = erow + ai * HM + wr * 64 + m * 16 + fr;
          float r = rs[row];
          if (epn < 14) {
            float* cdst = nullptr;
            bfr* tdst = nullptr;
            if (ecol >= 512 && ecol < 1536) {
              { int cid, tl;
                if (row < SROW0) { int s = row / PROW, pos = row % PROW; cid = s * 65 + (pos >> 6); tl = (pos & 63) - 61; }
                else { int rr = row - SROW0; cid = 520 + (rr >> 6); tl = (rr & 63) - 61; }
                if (tl >= 0) tdst = (bfr*)(p.ws + OFF_TAILS) + ((size_t)cid * 3 + tl) * 1024; }
              if (row < SROW0) { int s = row / PROW, tl = row % PROW - (PLEN - 3); if (tl >= 0 && tl < 3) cdst = p.out + O_CP + ((size_t)(l * 8 + s) * 3 + tl) * 1024; }
              else { int s = (row - SROW0) >> 6, tl = ((row - SROW0) & 63) - 61; if (tl >= 0) cdst = p.out + O_CS + ((size_t)(l * 8 + s) * 3 + tl) * 1024; }
            }
#pragma unroll
            for (int bj = 0; bj < 2; ++bj) {
              int col = ecol + bj * HALF + wc * 32 + fq * 8;
              float v[8];
#pragma unroll
              for (int j = 0; j < 4; ++j) { v[j] = acc[ai][bj][m][0][j] * r; v[4 + j] = acc[ai][bj][m][1][j] * r; }
              u32x4 pk; pk[0] = pack2(v[0], v[1]); pk[1] = pack2(v[2], v[3]); pk[2] = pack2(v[4], v[5]); pk[3] = pack2(v[6], v[7]);
              *(u32x4*)(proj + (size_t)row * NIN + col) = pk;
              if (cdst) { *(float4*)(cdst + col - 512) = make_float4(v[0], v[1], v[2], v[3]); *(float4*)(cdst + col - 512 + 4) = make_float4(v[4], v[5], v[6], v[7]); }
              if (tdst) *(u32x4*)(tdst + col - 512) = pk;
            }
          } else {
            if (wc == 0 && fq == 0) {
              *(float4*)(dtb + (size_t)row * 8) = make_float4(acc[ai][0][m][0][0] * r, acc[ai][0][m][0][1] * r, acc[ai][0][m][0][2] * r, acc[ai][0][m][0][3] * r);
              *(float4*)(dtb + (size_t)row * 8 + 4) = make_float4(acc[ai][0][m][1][0] * r, acc[ai][0][m][1][1] * r, acc[ai][0][m][1][2] * r, acc[ai][0][m][1][3] * r);
            }
          }
        }
    }
  }
#undef SA
#undef TILE_COORDS
#undef SB
#undef STAGE_A
#undef STAGE_B
#undef LDA
#undef LDB
#undef MMA
}

__device__ __forceinline__ f32x4 mma_lds(const bfr* A, int lda, const bfr* B, int ldb, int ksteps, f32x4 acc, int fr, int fq) {
  for (int ks = 0; ks < ksteps; ++ks) {
    bf16x8 a = *(const bf16x8*)(A + fr * lda + ks * 32 + fq * 8);
    bf16x8 b = *(const bf16x8*)(B + fr * ldb + ks * 32 + fq * 8);
    acc = __builtin_amdgcn_mfma_f32_16x16x32_bf16(a, b, acc, 0, 0, 0);
  }
  return acc;
}

__device__ __forceinline__ f32x4 mma_gl(const bf16x8* af, const bfr* B, int ldb, int ksteps, f32x4 acc, int fr, int fq) {
  bf16x8 b0 = *(const bf16x8*)(B + fr * ldb + 0 * 32 + fq * 8);
  bf16x8 b1 = *(const bf16x8*)(B + fr * ldb + 1 * 32 + fq * 8);
  bf16x8 b2 = *(const bf16x8*)(B + fr * ldb + 2 * 32 + fq * 8);
  bf16x8 b3 = *(const bf16x8*)(B + fr * ldb + 3 * 32 + fq * 8);
  f32x4 c0 = acc, c1 = f32x4{0.f, 0.f, 0.f, 0.f};
  c0 = __builtin_amdgcn_mfma_f32_16x16x32_bf16(af[0], b0, c0, 0, 0, 0);
  c1 = __builtin_amdgcn_mfma_f32_16x16x32_bf16(af[1], b1, c1, 0, 0, 0);
  c0 = __builtin_amdgcn_mfma_f32_16x16x32_bf16(af[2], b2, c0, 0, 0, 0);
  c1 = __builtin_amdgcn_mfma_f32_16x16x32_bf16(af[3], b3, c1, 0, 0, 0);
  (void)ksteps;
  return c0 + c1;
}

__device__ void ssd_pre(const KP& p, int l, int cid, int g) {
  extern __shared__ __attribute__((aligned(16))) unsigned char smem[];
  int tid_ = threadIdx.x; asm volatile("" : "+v"(tid_));
  const int tid = tid_, w = tid >> 6, lane = tid & 63, fr = lane & 15, fq = lane >> 4;
  bfr* Cs = (bfr*)smem;
  bfr* Bs = Cs + 64 * 136;
  bfr* BTs = Bs + 64 * 136;
  bfr* xTs = BTs + 128 * 72;
  bfr* Gs = xTs + 256 * 72;
  float* dtv = (float*)(Gs + 2 * 64 * 72);
  float* cumv = dtv + 256;
  float* ev = cumv + 256;

  bool prompt, first; int r0, pos0, len, sb = 0;
  if (cid < 520) { int s = cid / 65, c = cid % 65; prompt = true; first = (c == 0); r0 = s * PROW + c * 64; pos0 = c * 64; len = PLEN; }
  else { sb = cid - 520; prompt = false; first = true; r0 = SROW0 + sb * 64; pos0 = 0; len = 64; }
  bfr* proj = (bfr*)(p.ws + OFF_U);
  float* dtbuf = (float*)(p.ws + OFF_DT);
  bfr* mix = (bfr*)(p.ws + OFF_MIX);
  const bfr* tails = (const bfr*)(p.ws + OFF_TAILS);
  const float* convw = p.in[12] + (size_t)l * 4 * 1024;
  const float* convb = p.in[13] + (size_t)l * 1024;

  if (tid < 256) {
    int hh = tid >> 6, i = tid & 63, h = g * 4 + hh;
    float x = dtbuf[(size_t)(r0 + i) * 8 + h] + p.in[14][l * 8 + h];
    float dt = (x > 20.f) ? x : __logf(1.f + __expf(x));
    if (pos0 + i >= len) dt = 0.f;
    float cum = dt * (-__expf(p.in[15][l * 8 + h]));
#pragma unroll
    for (int o = 1; o < 64; o <<= 1) { float t = __shfl_up(cum, o); if (i >= o) cum += t; }
    float cl = __shfl(cum, 63);
    dtv[tid] = dt; cumv[tid] = cum; ev[tid] = dt * __expf(cl - cum);
    dtbuf[(size_t)(r0 + i) * 8 + h] = cum;
  }
  {
    const int item = tid;
    const int pair = item & 255, half_ = item >> 8, cc0 = pair * 2;
    const int rs_ = half_ * 32, re_ = rs_ + 32;
    const int ch = (cc0 < 256) ? (g * 256 + cc0) : ((cc0 < 384) ? (512 + g * 128 + cc0 - 256) : (768 + g * 128 + cc0 - 384));
    float w0[5], w1[5];
#pragma unroll
    for (int k = 0; k < 4; ++k) { w0[k] = convw[k * 1024 + ch]; w1[k] = convw[k * 1024 + ch + 1]; }
    w0[4] = convb[ch]; w1[4] = convb[ch + 1];
    float a0[3], a1[3];
#pragma unroll
    for (int k = 0; k < 3; ++k) {
      int rr = rs_ - 3 + k;
      float x0 = 0.f, x1 = 0.f;
      if (rr >= 0) { unsigned u = *(const unsigned*)(proj + (size_t)(r0 + rr) * NIN + 512 + ch); x0 = __uint_as_float(u << 16); x1 = __uint_as_float(u & 0xffff0000u); }
      else if (!first) { unsigned u = *(const unsigned*)(tails + ((size_t)(cid - 1) * 3 + (rr + 3)) * 1024 + ch); x0 = __uint_as_float(u << 16); x1 = __uint_as_float(u & 0xffff0000u); }
      else if (!prompt) { const float* sp = p.in[2] + (((size_t)l * 8 + sb) * 3 + (rr + 3)) * 1024 + ch; x0 = bf2f(f2bf(sp[0])); x1 = bf2f(f2bf(sp[1])); }
      a0[k] = x0; a1[k] = x1;
    }
    f32v2_t wv[5], av[3];
#pragma unroll
    for (int k = 0; k < 5; ++k) wv[k] = f32v2_t{w0[k], w1[k]};
#pragma unroll
    for (int k = 0; k < 3; ++k) av[k] = f32v2_t{a0[k], a1[k]};
    const bfr* gp = proj + (size_t)r0 * NIN + 512 + ch;
    int nin_ = NIN; asm volatile("" : "+s"(nin_));
    unsigned ur[32];
#pragma unroll
    for (int k = 0; k < 32; ++k) { int i = rs_ + k; ur[k] = *(const unsigned*)(gp + (size_t)i * nin_); }
#pragma unroll
    for (int k = 0; k < 32; ++k) {
      const int i = rs_ + k;
      if (i < re_) {
        unsigned u = ur[k];
        float x0 = __uint_as_float(u << 16), x1 = __uint_as_float(u & 0xffff0000u);
        f32v2_t xv = {x0, x1};
        f32v2_t vv = wv[4] + av[0] * wv[0] + av[1] * wv[1] + av[2] * wv[2] + xv * wv[3];
        av[0] = av[1]; av[1] = av[2]; av[2] = xv;
        f32v2_t tv = vv * -1.44269504f;
        f32v2_t ev = {__builtin_amdgcn_exp2f(tv.x), __builtin_amdgcn_exp2f(tv.y)};
        f32v2_t dv = ev + 1.0f;
        f32v2_t rv = {__builtin_amdgcn_rcpf(dv.x), __builtin_amdgcn_rcpf(dv.y)};
        vv = vv * rv;
        float v0 = vv.x, v1 = vv.y;
        if (cc0 < 256) { xTs[cc0 * 72 + i] = f2bf(v0); xTs[(cc0 + 1) * 72 + i] = f2bf(v1); }
        else if (cc0 < 384) {
          int n = cc0 - 256; unsigned pk = pack2(v0, v1);
          *(unsigned*)(Bs + i * 136 + n) = pk;
          BTs[n * 72 + i] = (bfr)(pk & 0xffffu); BTs[(n + 1) * 72 + i] = (bfr)(pk >> 16);
        } else *(unsigned*)(Cs + i * 136 + (cc0 - 384)) = pack2(v0, v1);
      }
    }
  }
  __syncthreads();
  f32x4 cb[2];
#pragma unroll
  for (int q = 0; q < 2; ++q) {
    int t = w * 2 + q, ti = t >> 2, tj = t & 3;
    cb[q] = f32x4{0.f, 0.f, 0.f, 0.f};
    if (tj <= ti) cb[q] = mma_lds(Cs + ti * 16 * 136, 136, Bs + tj * 16 * 136, 136, 4, cb[q], fr, fq);
  }
#pragma unroll
  for (int it = 0; it < 2; ++it) {
    int e = tid + 512 * it;
    { int i = e >> 4, sg = e & 15; *(u32x4*)(proj + (size_t)(r0 + i) * NIN + 1280 + g * 128 + sg * 8) = *(const u32x4*)(Cs + i * 136 + sg * 8); }
    { int n = e >> 3, sg = e & 7; *(u32x4*)(proj + (size_t)(r0 + (n >> 1)) * NIN + 1024 + g * 128 + (n & 1) * 64 + sg * 8) = *(const u32x4*)(BTs + n * 72 + sg * 8); }
  }
#pragma unroll
  for (int it = 0; it < 4; ++it) {
    int e = tid + 512 * it, xr = e >> 3, sg = e & 7, hh = xr >> 6, pp = xr & 63;
    u32x4 v = *(const u32x4*)(xTs + xr * 72 + sg * 8), o;
#pragma unroll
    for (int k = 0; k < 4; ++k) {
      float e0 = ev[hh * 64 + sg * 8 + 2 * k], e1 = ev[hh * 64 + sg * 8 + 2 * k + 1];
      o[k] = pack2(__uint_as_float(v[k] << 16) * e0, __uint_as_float(v[k] & 0xffff0000u) * e1);
    }
    *(u32x4*)(proj + (size_t)(r0 + pp) * NIN + 512 + (g * 4 + hh) * 64 + sg * 8) = o;
  }
  for (int hh = 0; hh < 4; ++hh) {
    const int h = g * 4 + hh;
    const float Dh = p.in[16][l * 8 + h];
    bfr* Gh = Gs + (hh & 1) * (64 * 72);
#pragma unroll
    for (int q = 0; q < 2; ++q) {
      int t = w * 2 + q, ti = t >> 2, tj = t & 3, jx = tj * 16 + fr;
      float cj = cumv[hh * 64 + jx], dj = dtv[hh * 64 + jx];
#pragma unroll
      for (int j = 0; j < 4; ++j) {
        int i = ti * 16 + fq * 4 + j;
        float gv = (tj <= ti && jx <= i) ? cb[q][j] * __expf(cumv[hh * 64 + i] - cj) * dj : 0.f;
        Gh[i * 72 + jx] = f2bf(gv);
      }
    }
    __syncthreads();
#pragma unroll
    for (int q = 0; q < 2; ++q) {
      int t = w * 2 + q, ti = t >> 2, tp = t & 3;
      f32x4 a = f32x4{0.f, 0.f, 0.f, 0.f};
      a = mma_lds(Gh + ti * 16 * 72, 72, xTs + (hh * 64 + tp * 16) * 72, 72, 2, a, fr, fq);
      int pp = tp * 16 + fr;
#pragma unroll
      for (int j = 0; j < 4; ++j) {
        int i = ti * 16 + fq * 4 + j;
        float y = a[j] + Dh * bf2f(xTs[(hh * 64 + pp) * 72 + i]);
        mix[(size_t)(r0 + i) * DM + h * 64 + pp] = f2bf(y);
      }
    }
  }
  __syncthreads();
}

__device__ __forceinline__ void store_bf16_asm(bfr* addr, unsigned v) { asm volatile("global_store_short %0, %1, off" :: "v"(addr), "v"(v) : "memory"); }

__device__ void ssd_seq(const KP& p, int l, int s, int h, int ph) {
  extern __shared__ __attribute__((aligned(16))) unsigned char smem[];
  int tid_ = threadIdx.x; asm volatile("" : "+v"(tid_));
  const int tid = tid_, w = tid >> 6, lane = tid & 63, fr = lane & 15, fq = lane >> 4;
  bfr* Sbs = (bfr*)smem;
  const bool prompt = s < 8;
  const int sb = s & 7;
  const int row0 = prompt ? s * PROW : SROW0 + sb * 64;
  const int nch = prompt ? 65 : 1, len = prompt ? PLEN : 64;
  const int g = h >> 2;
  const bfr* proj = (const bfr*)(p.ws + OFF_U);
  const float* cumb = (const float*)(p.ws + OFF_DT);
  bfr* mix = (bfr*)(p.ws + OFF_MIX);
  const int ti = w >> 1, tp = w & 1;
  const int zc = h * 64 + ph * 32 + tp * 16 + fr;

  f32x4 Sacc[2];
#pragma unroll
  for (int pt = 0; pt < 2; ++pt)
#pragma unroll
    for (int j = 0; j < 4; ++j) {
      int pp = pt * 16 + fq * 4 + j, n = 16 * w + fr;
      float v = 0.f;
      if (!prompt) v = p.in[3][((((size_t)l * 8 + sb) * 8 + h) * 64 + ph * 32 + pp) * 128 + n];
      Sacc[pt][j] = v;
      Sbs[pp * 136 + n] = f2bf(v);
    }
  __syncthreads();

  bf16x8 Cs_[2][4], Xs_[2][2][2], Bs_[2][2];
  bfr ys_[2][4], zs_[2][4]; float cus_[2][4], cls_[2];
  const int nB = 16 * w + fr;
#define LBAR() do { asm volatile("s_waitcnt lgkmcnt(0)" ::: "memory"); __builtin_amdgcn_s_barrier(); asm volatile("" ::: "memory"); } while (0)
  const unsigned coff = (unsigned)(((ti * 16 + fr) * NIN + 1280 + g * 128 + fq * 8) * 2);
  unsigned xoff[2];
#pragma unroll
  for (int pt = 0; pt < 2; ++pt) xoff[pt] = (unsigned)(((ph * 32 + pt * 16 + fr) * NIN + 512 + h * 64 + fq * 8) * 2);
  const unsigned boff = (unsigned)((((nB >> 1)) * NIN + 1024 + g * 128 + (nB & 1) * 64 + fq * 8) * 2);
  const unsigned zoff = (unsigned)(((ti * 16 + fq * 4) * NIN + zc) * 2);
  const unsigned yoff = (unsigned)(((ti * 16 + fq * 4) * DM + zc) * 2);
  const unsigned cuoff = (unsigned)(((ti * 16 + fq * 4) * 8 + h) * 4);
#define SSD_LOAD(SET, R0) do { const int _r0 = (R0); \
    const char* _pb = (const char*)proj + (size_t)_r0 * (NIN * 2); \
    const char* _mb = (const char*)mix + (size_t)_r0 * (DM * 2); \
    const char* _cb = (const char*)cumb + (size_t)_r0 * 32; \
    for (int ks = 0; ks < 4; ++ks) Cs_[SET][ks] = *(const bf16x8*)(_pb + coff + ks * 64); \
    for (int pt = 0; pt < 2; ++pt) for (int ks = 0; ks < 2; ++ks) Xs_[SET][pt][ks] = *(const bf16x8*)(_pb + xoff[pt] + ks * 64); \
    for (int ks = 0; ks < 2; ++ks) Bs_[SET][ks] = *(const bf16x8*)(_pb + boff + ks * 64); \
    for (int j = 0; j < 4; ++j) { ys_[SET][j] = *(const bfr*)(_mb + yoff + j * (DM * 2)); zs_[SET][j] = *(const bfr*)(_pb + zoff + j * (NIN * 2)); cus_[SET][j] = *(const float*)(_cb + cuoff + j * 32); } \
    cls_[SET] = *(const float*)(_cb + (63 * 8 + h) * 4); } while (0)
#define SSD_STEP(k, c) do { const int r0 = row0 + (c) * 64; \
    { f32x4 a2 = f32x4{0.f, 0.f, 0.f, 0.f}; \
      a2 = mma_gl(Cs_[k], Sbs + ((k) & 1) * (32 * 136) + tp * 16 * 136, 136, 4, a2, fr, fq); \
      for (int j = 0; j < 4; ++j) { \
        int i = ti * 16 + fq * 4 + j; \
        float y = bf2f(ys_[k][j]) + __expf(cus_[k][j]) * a2[j]; \
        float yz = y * siluf(bf2f(zs_[k][j])); \
        if ((c) * 64 + i >= len) yz = 0.f; \
        store_bf16_asm((bfr*)((char*)mix + (size_t)r0 * (DM * 2) + yoff + j * (DM * 2)), (unsigned)f2bf(yz)); \
      } } \
    { float dec = __expf(cls_[k]); \
      for (int pt = 0; pt < 2; ++pt) { \
        f32x4 a = Sacc[pt]; \
        a[0] *= dec; a[1] *= dec; a[2] *= dec; a[3] *= dec; \
        for (int ks = 0; ks < 2; ++ks) a = __builtin_amdgcn_mfma_f32_16x16x32_bf16(Xs_[k][pt][ks], Bs_[k][ks], a, 0, 0, 0); \
        Sacc[pt] = a; \
        for (int j = 0; j < 4; ++j) Sbs[(((k) + 1) & 1) * (32 * 136) + (pt * 16 + fq * 4 + j) * 136 + 16 * w + fr] = f2bf(a[j]); \
      } } } while (0)
#pragma unroll
  for (int k = 0; k < 2; ++k) SSD_LOAD(k, row0 + min(k, nch - 1) * 64);
  int c0 = 0;
  for (; c0 + 1 < nch; c0 += 2) {
#pragma unroll
    for (int k = 0; k < 2; ++k) {
      const int c = c0 + k;
      SSD_STEP(k, c);
      SSD_LOAD(k, row0 + min(c + 2, nch - 1) * 64);
      LBAR();
    }
  }
  if (c0 < nch) { SSD_STEP(0, c0); LBAR(); }
#undef SSD_STEP
#undef LBAR
#undef SSD_LOAD
  float* so = p.out + (prompt ? O_SP : O_SS) + (((size_t)l * 8 + sb) * 8 + h) * 64 * 128;
#pragma unroll
  for (int pt = 0; pt < 2; ++pt)
#pragma unroll
    for (int j = 0; j < 4; ++j) so[(size_t)(ph * 32 + pt * 16 + fq * 4 + j) * 128 + 16 * w + fr] = Sacc[pt][j];
}

__device__ __forceinline__ void gla_pre(const KP& p, int l, int sbid, int h, bfr (&qn)[8], bfr (&fn)[8], u32x4& vv, bool have, bool want_next) {
  extern __shared__ __attribute__((aligned(16))) unsigned char smem[];
  int tid_ = threadIdx.x; asm volatile("" : "+v"(tid_));
  const int tid = tid_, w = tid >> 6, lane = tid & 63, fr = lane & 15, fq = lane >> 4;
  bfr* qes = (bfr*)smem;
  bfr* kes = qes + 32 * 136;
  bfr* kdTs = kes + 32 * 136;
  bfr* vTs = kdTs + 128 * 40;
  bfr* atts = vTs + 128 * 40;
  float* segs = (float*)(atts + 32 * 40);

  int r0, pos0, len;
  if (sbid < 1040) { int s = sbid / 130, st = sbid % 130; r0 = s * PROW + st * 32; pos0 = st * 32; len = PLEN; }
  else { int x = sbid - 1040; r0 = SROW0 + x * 32; pos0 = (x & 1) * 32; len = 64; }
  bfr* proj = (bfr*)(p.ws + OFF_U);
  bfr* mix = (bfr*)(p.ws + OFF_MIX);
  float* decb = (float*)(p.ws + OFF_DEC);
  const int kk_ = tid & 127, seg = tid >> 7;
  float lb = 0.f;
  if (l == 1) {
    float d = p.in[18][512 + h * 128 + kk_] - p.in[18][h * 128 + kk_];
    lb = fminf(__fdividef(1.f, 1.f + __expf(-d)), 1.f - 1e-6f);
  }
  float qv[8], kv[8], cm[8];
#define GLAPRE_LOAD(H) do { \
    for (int it = 0; it < 8; ++it) { size_t rb = (size_t)(r0 + seg * 8 + it) * NIN; \
      qn[it] = proj[rb + 1536 + (H) * 128 + kk_]; fn[it] = proj[rb + 2048 + (H) * 128 + kk_]; } \
    { int j = tid >> 4, sg = tid & 15; vv = *(const u32x4*)(proj + (size_t)(r0 + j) * NIN + 2560 + (H) * 128 + sg * 8); } } while (0)
  if (!have) GLAPRE_LOAD(h);
  {
    float run = 0.f;
#pragma unroll
    for (int it = 0; it < 8; ++it) {
      int j = seg * 8 + it;
      float hq = bf2f(qn[it]), fx = bf2f(fn[it]);
      qv[it] = siluf(hq);
      float ex_ = __expf(fx);
      float sg_ = __fdividef(1.f, 1.f + ex_);
      float kkv = (1.f - lb) * sg_;
      float fsel = (kkv < 0.5f) ? (1.f - kkv) : fmaxf(lb + (1.f - lb) * ex_ * sg_, 1e-30f);
      float lf = __logf(fsel);
      if (pos0 + j >= len) { kkv = 0.f; lf = 0.f; }
      kv[it] = kkv;
      run += lf; cm[it] = run;
    }
    segs[seg * 128 + kk_] = run;
    { int j = tid >> 4, sg = tid & 15;
#pragma unroll
      for (int k = 0; k < 4; ++k) { vTs[(sg * 8 + 2 * k) * 40 + j] = (bfr)(vv[k] & 0xffffu); vTs[(sg * 8 + 2 * k + 1) * 40 + j] = (bfr)(vv[k] >> 16); } }
  }
  __syncthreads();
  if (want_next) GLAPRE_LOAD(h + 1);
#undef GLAPRE_LOAD
  {
    float s0 = segs[kk_], s1 = segs[128 + kk_], s2 = segs[256 + kk_], s3 = segs[384 + kk_];
    float base = (seg > 0 ? s0 : 0.f) + (seg > 1 ? s1 : 0.f) + (seg > 2 ? s2 : 0.f);
    float cl = s0 + s1 + s2 + s3;
    const float ecl = __expf(cl);
    if (seg == 0) decb[((size_t)sbid * 4 + h) * 128 + kk_] = ecl;
#pragma unroll
    for (int it = 0; it < 8; ++it) {
      int j = seg * 8 + it;
      float c = base + cm[it];
      float en = __expf(-c), kn = kv[it] * en;
      qes[j * 136 + kk_] = f2bf(qv[it] * __expf(c));
      kes[j * 136 + kk_] = f2bf(kn);
      kdTs[kk_ * 40 + j] = f2bf(kn * ecl);
    }
  }
  asm volatile("s_waitcnt lgkmcnt(0)" ::: "memory"); __builtin_amdgcn_s_barrier(); asm volatile("" ::: "memory");
  if (w < 4) {
    int ti = w >> 1, tj = w & 1;
    f32x4 a = f32x4{0.f, 0.f, 0.f, 0.f};
    if (tj <= ti) a = mma_lds(qes + ti * 16 * 136, 136, kes + tj * 16 * 136, 136, 4, a, fr, fq);
    int jx = tj * 16 + fr;
#pragma unroll
    for (int j = 0; j < 4; ++j) {
      int i = ti * 16 + fq * 4 + j;
      atts[i * 40 + jx] = f2bf((tj <= ti && jx <= i) ? a[j] : 0.f);
    }
  }
  { int j = tid >> 4, sg = tid & 15; *(u32x4*)(proj + (size_t)(r0 + j) * NIN + 1536 + h * 128 + sg * 8) = *(const u32x4*)(qes + j * 136 + sg * 8); }
  { int k = tid >> 2, sg = tid & 3;
    *(u32x4*)(proj + (size_t)(r0 + (k >> 2)) * NIN + 2048 + h * 128 + (k & 3) * 32 + sg * 8) = *(const u32x4*)(kdTs + k * 40 + sg * 8);
    *(u32x4*)(proj + (size_t)(r0 + (k >> 2)) * NIN + 2560 + h * 128 + (k & 3) * 32 + sg * 8) = *(const u32x4*)(vTs + k * 40 + sg * 8); }
  asm volatile("s_waitcnt lgkmcnt(0)" ::: "memory"); __builtin_amdgcn_s_barrier(); asm volatile("" ::: "memory");
#pragma unroll
  for (int q = 0; q < 2; ++q) {
    int t = w * 2 + q, ti = t >> 3, tv = t & 7;
    f32x4 a = f32x4{0.f, 0.f, 0.f, 0.f};
    a = mma_lds(atts + ti * 16 * 40, 40, vTs + tv * 16 * 40, 40, 1, a, fr, fq);
#pragma unroll
    for (int j = 0; j < 4; ++j) {
      int i = ti * 16 + fq * 4 + j;
      mix[(size_t)(r0 + i) * DM + 512 + h * 128 + tv * 16 + fr] = f2bf(a[j]);
    }
  }
  asm volatile("s_waitcnt lgkmcnt(0)" ::: "memory"); __builtin_amdgcn_s_barrier(); asm volatile("" ::: "memory");
}

__device__ void gla_seq(const KP& p, int l, int s, int h, int vq) {
  extern __shared__ __attribute__((aligned(16))) unsigned char smem[];
  int tid_ = threadIdx.x; asm volatile("" : "+v"(tid_));
  const int tid = tid_, w = tid >> 6, lane = tid & 63, fr = lane & 15, fq = lane >> 4;
  bfr* STs = (bfr*)smem;
  const bool prompt = s < 8;
  const int sb = s & 7;
  const int row0 = prompt ? s * PROW : SROW0 + sb * 64;
  const int nst = prompt ? 130 : 2, len = prompt ? PLEN : 64;
  const int sbid0 = prompt ? s * 130 : 1040 + sb * 2;
  const bfr* proj = (const bfr*)(p.ws + OFF_U);
  const float* decb = (const float*)(p.ws + OFF_DEC);
  bfr* mix = (bfr*)(p.ws + OFF_MIX);
  const int ti = (w >> 1) & 1, tv = w & 1;
  const int oc = 512 + h * 128 + vq * 32 + tv * 16 + fr;

  f32x4 Sacc[2];
#pragma unroll
  for (int vt = 0; vt < 2; ++vt)
#pragma unroll
    for (int j = 0; j < 4; ++j) {
      int k = 16 * w + fq * 4 + j, v = vt * 16 + fr;
      float x = 0.f;
      if (!prompt) x = p.in[4][((((size_t)l * 8 + sb) * 4 + h) * 128 + k) * 128 + vq * 32 + v];
      Sacc[vt][j] = x;
      STs[v * 136 + k] = f2bf(x);
    }
  __syncthreads();

  bf16x8 Qs[4][4], Ks[4], Vs[4][2];
  bfr os_[4][4]; float ds_[4][4];
  const int kA = 16 * w + fr;
#define LBAR() do { asm volatile("s_waitcnt lgkmcnt(0)" ::: "memory"); __builtin_amdgcn_s_barrier(); asm volatile("" ::: "memory"); } while (0)
  const unsigned qoff = (unsigned)(((ti * 16 + fr) * NIN + 1536 + h * 128 + fq * 8) * 2);
  const unsigned koff = (unsigned)((((kA >> 2)) * NIN + 2048 + h * 128 + (kA & 3) * 32 + fq * 8) * 2);
  unsigned voff[2];
#pragma unroll
  for (int vt = 0; vt < 2; ++vt) { int _v = vq * 32 + vt * 16 + fr; voff[vt] = (unsigned)(((_v >> 2) * NIN + 2560 + h * 128 + (_v & 3) * 32 + fq * 8) * 2); }
  const unsigned ooff = (unsigned)(((ti * 16 + fq * 4) * DM + oc) * 2);
  const unsigned doff = (unsigned)((h * 128 + 16 * w + fq * 4) * 4);
#define GLA_LOAD(SET, ST) do { const int _st = (ST); \
    const char* _pb = (const char*)proj + (size_t)(row0 + _st * 32) * (NIN * 2); \
    const char* _mb = (const char*)mix + (size_t)(row0 + _st * 32) * (DM * 2); \
    const char* _db = (const char*)decb + (size_t)(sbid0 + _st) * (4 * 128 * 4); \
    for (int ks = 0; ks < 4; ++ks) Qs[SET][ks] = *(const bf16x8*)(_pb + qoff + ks * 64); \
    for (int j = 0; j < 4; ++j) os_[SET][j] = *(const bfr*)(_mb + ooff + j * (DM * 2)); \
    Ks[SET] = *(const bf16x8*)(_pb + koff); \
    for (int vt = 0; vt < 2; ++vt) Vs[SET][vt] = *(const bf16x8*)(_pb + voff[vt]); \
    { const f32x4 _d = *(const f32x4*)(_db + doff); ds_[SET][0] = _d[0]; ds_[SET][1] = _d[1]; ds_[SET][2] = _d[2]; ds_[SET][3] = _d[3]; } } while (0)
#define GLA_STEP(k, st) do { const int r0 = row0 + (st) * 32; \
    if (w < 4) { \
      f32x4 a = f32x4{0.f, 0.f, 0.f, 0.f}; \
      a = mma_gl(Qs[k], STs + ((k) & 1) * (32 * 136) + tv * 16 * 136, 136, 4, a, fr, fq); \
      for (int j = 0; j < 4; ++j) { \
        int i = ti * 16 + fq * 4 + j; \
        float o = bf2f(os_[k][j]) + a[j]; \
        if ((st) * 32 + i >= len) o = 0.f; \
        store_bf16_asm((bfr*)((char*)mix + (size_t)r0 * (DM * 2) + ooff + j * (DM * 2)), (unsigned)f2bf(o)); \
      } \
    } \
    for (int vt = 0; vt < 2; ++vt) { \
      f32x4 a = Sacc[vt]; \
      for (int j = 0; j < 4; ++j) a[j] *= ds_[k][j]; \
      a = __builtin_amdgcn_mfma_f32_16x16x32_bf16(Ks[k], Vs[k][vt], a, 0, 0, 0); \
      Sacc[vt] = a; \
      for (int j = 0; j < 4; ++j) STs[(((k) + 1) & 1) * (32 * 136) + (vt * 16 + fr) * 136 + 16 * w + fq * 4 + j] = f2bf(a[j]); \
    } } while (0)
#pragma unroll
  for (int k = 0; k < 4; ++k) GLA_LOAD(k, min(k, nst - 1));
  int st0 = 0;
  for (; st0 + 3 < nst; st0 += 4) {
#pragma unroll
    for (int k = 0; k < 4; ++k) {
      const int st = st0 + k;
      GLA_STEP(k, st);
      GLA_LOAD(k, min(st + 4, nst - 1));
      LBAR();
    }
  }
#pragma unroll
  for (int k = 0; k < 4; ++k) {
    const int st = st0 + k;
    if (st < nst) { GLA_STEP(k, st); LBAR(); }
  }
#undef GLA_STEP
#undef LBAR
#undef GLA_LOAD
  float* so = p.out + (prompt ? O_HP : O_HS) + (((size_t)l * 8 + sb) * 4 + h) * 128 * 128;
#pragma unroll
  for (int vt = 0; vt < 2; ++vt)
#pragma unroll
    for (int j = 0; j < 4; ++j) so[(size_t)(16 * w + fq * 4 + j) * 128 + vq * 32 + vt * 16 + fr] = Sacc[vt][j];
}

__device__ void phase_pre(const KP& p, int l) {
  for (int u = p.bid; u < 1056; u += p.nblk) ssd_pre(p, l, u >> 1, u & 1);
  int lo, hi;
  if (p.nblk == 256) { if (p.bid < 32) { lo = p.bid * 13; hi = lo + 13; } else { lo = 416 + (p.bid - 32) * 17; hi = lo + 17; } }
  else { lo = (int)((long)4224 * p.bid / p.nblk); hi = (int)((long)4224 * (p.bid + 1) / p.nblk); }
  bfr qn[8], fn[8]; u32x4 vv;
  for (int v = lo; v < hi; ++v) {
    const bool have = (v > lo) && ((v & 3) != 0);
    const bool want = (v + 1 < hi) && (((v + 1) & 3) != 0);
    gla_pre(p, l, v >> 2, v & 3, qn, fn, vv, have, want);
  }
}

__device__ void phase_seq(const KP& p, int l) {
  for (int u = p.bid; u < 512; u += p.nblk) {
    int uu = u & 255, soff = (u >= 256) ? 8 : 0;
    if (uu < 128) ssd_seq(p, l, soff + (uu >> 4), (uu & 15) >> 1, uu & 1);
    else { int v = uu - 128; gla_seq(p, l, soff + (v >> 4), (v & 15) >> 2, v & 3); }
    __syncthreads();
  }
}


#define XB_TMO      128
#define XB_XCNT(j)  (256  + 64 * (j))
#define XB_XSUB(j)  (1280 + 64 * (j))
#define XB_XGEN(j)  (2304 + 64 * (j))
#define XB_TOP      3328
#define XB_TOPGEN   3392
#define XCD_BAR_WORDS 3456
#define XB_SPIN_CAP (1u << 18)
#define LAS __attribute__((address_space(3)))
__device__ __forceinline__ unsigned xb_ld(unsigned* p)              { return __hip_atomic_load(p, __ATOMIC_RELAXED, __HIP_MEMORY_SCOPE_AGENT); }
__device__ __forceinline__ unsigned xb_add(unsigned* p, unsigned v) { return __hip_atomic_fetch_add(p, v, __ATOMIC_RELAXED, __HIP_MEMORY_SCOPE_AGENT); }
__device__ __forceinline__ unsigned xb_xcc_id() { return (unsigned)__builtin_amdgcn_s_getreg((3 << 11) | 20) & 0xFu; }
#define XB_SPIN(cond, bar) do { unsigned _sp = 0; while (cond) { __builtin_amdgcn_s_sleep(1); \
    if ((++_sp & 255u) == 0u) { if (xb_ld(&(bar)[XB_TMO])) break; if (_sp > XB_SPIN_CAP) { atomicAdd(&(bar)[XB_TMO], 1u); break; } } } } while (0)
struct XcdBarrier { unsigned* bar; unsigned x; volatile LAS unsigned* st; };
__device__ __forceinline__ XcdBarrier xcd_barrier_post(unsigned* bar, volatile LAS unsigned* st) {
  XcdBarrier b; b.bar = bar; b.x = xb_xcc_id(); b.st = st;
  if (threadIdx.x == 0) (void)xb_add(&bar[XB_XCNT(b.x)], 1u);
  return b;
}
__device__ __forceinline__ void xcd_barrier_complete(unsigned* bar, unsigned x, unsigned& nloc, unsigned& nx) {
  const unsigned G = gridDim.x * gridDim.y * gridDim.z;
  unsigned sum, cnt, mine, sp = 0u;
  for (;;) {
    sum = 0u; cnt = 0u; mine = 0u;
#pragma unroll
    for (unsigned j = 0; j < 16; ++j) { const unsigned c = xb_ld(&bar[XB_XCNT(j)]); sum += c; cnt += (c > 0u) ? 1u : 0u; mine = (j == x) ? c : mine; }
    if (sum == G) break;
    __builtin_amdgcn_s_sleep(1);
    if ((++sp & 255u) == 0u) { if (xb_ld(&bar[XB_TMO])) break; if (sp > XB_SPIN_CAP) { atomicAdd(&bar[XB_TMO], 1u); break; } }
  }
  nloc = mine > 0u ? mine : 1u; nx = cnt > 0u ? cnt : 1u;
}
__device__ __forceinline__ void xcd_barrier(const XcdBarrier& b) {
  asm volatile("s_waitcnt vmcnt(0)" ::: "memory");
  __syncthreads();
  if (threadIdx.x == 0) {
    unsigned* bar = b.bar; asm volatile("" : "+s"(bar));
    __builtin_amdgcn_s_waitcnt(0);
    unsigned nloc = b.st[0], nx = b.st[1];
    if (nloc == 0u) { xcd_barrier_complete(bar, b.x, nloc, nx); b.st[0] = nloc; b.st[1] = nx; }
    const unsigned old = xb_add(&bar[XB_XSUB(b.x)], 1u);
    const unsigned gen = old / nloc;
    if (old + 1u == (gen + 1u) * nloc) {
      __builtin_amdgcn_fence(__ATOMIC_RELEASE, "agent");
      asm volatile("s_waitcnt vmcnt(0)" ::: "memory");
      const unsigned og = xb_add(&bar[XB_TOP], 1u);
      const unsigned tg = og / nx;
      if (og + 1u == (tg + 1u) * nx) xb_add(&bar[XB_TOPGEN], 1u);
      else XB_SPIN(xb_ld(&bar[XB_TOPGEN]) == tg, bar);
      __builtin_amdgcn_fence(__ATOMIC_ACQUIRE, "agent");
      xb_add(&bar[XB_XGEN(b.x)], 1u);
      asm volatile("s_waitcnt vmcnt(0)" ::: "memory");
    } else {
      XB_SPIN(xb_ld(&bar[XB_XGEN(b.x)]) == gen, bar);
      __builtin_amdgcn_fence(__ATOMIC_ACQUIRE, "agent");
      asm volatile("s_waitcnt vmcnt(0)" ::: "memory");
    }
  }
  __syncthreads();
}

__device__ void run_phase(const KP& p_, int ph) {
  KP p = p_;
  {
    unsigned long long w_ = (unsigned long long)p_.ws, o_ = (unsigned long long)p_.out;
    unsigned wl = __builtin_amdgcn_readfirstlane((unsigned)w_), wh = __builtin_amdgcn_readfirstlane((unsigned)(w_ >> 32));
    unsigned ol = __builtin_amdgcn_readfirstlane((unsigned)o_), oh = __builtin_amdgcn_readfirstlane((unsigned)(o_ >> 32));
    int b_ = __builtin_amdgcn_readfirstlane((int)blockIdx.x), n_ = __builtin_amdgcn_readfirstlane((int)gridDim.x);
    asm volatile("" : "+s"(wl), "+s"(wh), "+s"(ol), "+s"(oh), "+s"(b_), "+s"(n_));
    p.ws = (unsigned char*)(__attribute__((address_space(1))) unsigned char*)(((unsigned long long)wh << 32) | (unsigned long long)wl);
    p.out = (float*)(__attribute__((address_space(1))) float*)(((unsigned long long)oh << 32) | (unsigned long long)ol);
    p.bid = b_; p.nblk = n_;
  }
  const bfr* W = (const bfr*)(p.ws + OFF_W);
  const bfr* hb = (const bfr*)(p.ws + OFF_HB);
  const bfr* U = (const bfr*)(p.ws + OFF_U);
  const bfr* mix = (const bfr*)(p.ws + OFF_MIX);
  int plo = 0, phi = 0, pfirst = 16;
  if (ph == 0) { phi = 1408; pfirst = 0; }
  else {
    int l = (ph - 1) / 12, q = (ph - 1) % 12;
    const bfr* Wl = W + (size_t)l * W_LAYER;
    if (q == 2 || q == 8 || (q == 11 && l == 0)) { phase_stat(p); return; }
    if (q == 11) { phase_final(p); return; }
    if (q == 4) { phase_pre(p, l); return; }
    if (q == 5) { phase_seq(p, l); return; }
    if (q == 6) { phase_mixnorm(p, l); return; }
    if (q == 0) { gemm_phase<1, NGU, DM>(p, l, hb, Wl + W_GUA); if (l == 0) { plo = 1408; phi = 2112; pfirst = (132 * 22) % p.nblk; } }
    else if (q == 1) { gemm_phase<2, DM, DFF>(p, l, U, Wl + W_DA); if (l == 0) { plo = 2112; phi = 5440; } else { plo = 7552; phi = 10880; } }
    else if (q == 3) gemm_phase<3, NINP, DM>(p, l, hb, Wl + W_IN);
    else if (q == 7) { gemm_phase<2, DM, DM>(p, l, mix, Wl + W_OUT); if (l == 0) { plo = 5440; phi = 6140; } }
    else if (q == 9) gemm_phase<1, NGU, DM>(p, l, hb, Wl + W_GUB);
    else { gemm_phase<2, DM, DFF>(p, l, U, Wl + W_DB); if (l == 0) { plo = 6140; phi = 7552; } }
  }
  if (phi > plo) { __syncthreads(); phase_prep(p, plo, phi, pfirst); }
  if (ph == 0) phase_init(p);
}

__global__ void __launch_bounds__(512, 2) hymba_fwd(KP p) {
  extern __shared__ __attribute__((aligned(16))) unsigned char smem[];
  volatile LAS unsigned* st = (volatile LAS unsigned*)(smem + 131072);
  if (threadIdx.x == 0) { st[0] = 0u; st[1] = 0u; }
  __syncthreads();
  XcdBarrier xb = xcd_barrier_post((unsigned*)(p.ws + OFF_BAR), st);
  for (int ph = p.ph_lo; ph < p.ph_hi; ++ph) {
    run_phase(p, ph);
    if (ph + 1 < p.ph_hi) { if (ph < 0) cg::this_grid().sync(); else xcd_barrier(xb); }
  }
}

extern "C" void kernel_launch(void* const* d_in, const int* in_sizes, int n_in, void* d_out, int out_size,
                              void* d_ws, size_t ws_size, hipStream_t stream) {
  static int grid = 0;
  if (!grid) {
    int dev = 0, cus = 0, per_cu = 0;
    hipGetDevice(&dev);
    hipDeviceGetAttribute(&cus, hipDeviceAttributeMultiprocessorCount, dev);
    hipFuncSetAttribute((const void*)hymba_fwd, hipFuncAttributeMaxDynamicSharedMemorySize, LDS_BYTES);
    hipOccupancyMaxActiveBlocksPerMultiprocessor(&per_cu, (const void*)hymba_fwd, 512, LDS_BYTES);
    if (per_cu < 1) per_cu = 1;
    grid = cus * per_cu;
    if (grid > 256) grid = 256;
  }
  hipMemsetAsync((char*)d_ws + OFF_BAR, 0, XCD_BAR_WORDS * 4, stream);
  KP p{};
  for (int i = 0; i < 26; ++i) p.in[i] = (const float*)d_in[i];
  p.out = (float*)d_out; p.ws = (unsigned char*)d_ws;
#if SINGLE_LAUNCH
  p.ph_lo = 0; p.ph_hi = NPHASE;
  void* args[] = {&p};
  hipError_t e = hipLaunchCooperativeKernel((const void*)hymba_fwd, dim3(grid), dim3(512), args, LDS_BYTES, stream);
  if (e != hipSuccess) fprintf(stderr, "cooperative launch failed: %s (grid %d)\n", hipGetErrorString(e), grid);
#else
  for (int ph = 0; ph < NPHASE; ++ph) {
    p.ph_lo = ph; p.ph_hi = ph + 1;
    hipLaunchKernelGGL(hymba_fwd, dim3(grid), dim3(512), LDS_BYTES, stream, p);
  }
#endif
}
```

```cpp
#include <hip/hip_runtime.h>
#include <hip/hip_bf16.h>
#include <hip/hip_cooperative_groups.h>
#include <cstdio>
namespace cg = cooperative_groups;

#ifndef SINGLE_LAUNCH
#define SINGLE_LAUNCH 1
#endif

typedef unsigned short bfr;
using bf16x8 = __attribute__((ext_vector_type(8))) short;
using f32x4  = __attribute__((ext_vector_type(4))) float;
using u32x4  = __attribute__((ext_vector_type(4))) unsigned;

constexpr int T_ROWS = 33792;
constexpr int PROW = 4160, PLEN = 4112, SROW0 = 33280;
constexpr int DM = 1024, DFF = 2816, NGU = 5632, NIN = 3584, NINP = 3840;
constexpr float EPSF = 1e-6f;
constexpr size_t OFF_HB = 0;
constexpr size_t OFF_RS = 69206016;
constexpr size_t OFF_DT = 69341184;
constexpr size_t OFF_U = 70422528;
constexpr size_t OFF_MIX = 312643584;
constexpr size_t OFF_W = 381849600;
constexpr size_t W_GUA = 0, W_DA = 5767168, W_IN = 8650752, W_OUT = 12582912, W_GUB = 13631488, W_DB = 19398656, W_LAYER = 22282240;
constexpr size_t O_YP = 0, O_YS = 33554432, O_CP = 34078720, O_SP = 34127872, O_HP = 35176448, O_CS = 36225024, O_SS = 36274176, O_HS = 37322752;
constexpr size_t OFF_TAILS = 470978560;
constexpr size_t OFF_DEC = 474222592;
constexpr size_t OFF_BAR = 476385280;
constexpr int LDS_BYTES = 131072 + 16;
constexpr int NPHASE = 25;

struct KP {
  const float* in[26];
  float* out;
  unsigned char* ws;
  int ph_lo, ph_hi;
  int bid, nblk;
};

typedef __bf16 bf16v2_t __attribute__((ext_vector_type(2)));
typedef float f32v2_t __attribute__((ext_vector_type(2)));
__device__ __forceinline__ unsigned pack2(float a, float b) { f32v2_t v = {a, b}; bf16v2_t r = __builtin_convertvector(v, bf16v2_t); return __builtin_bit_cast(unsigned, r); }
__device__ __forceinline__ bfr f2bf(float f) { return (bfr)(pack2(f, f) & 0xffffu); }
__device__ __forceinline__ float bf2f(bfr b) { return __uint_as_float(((unsigned)b) << 16); }
__device__ __forceinline__ float siluf(float x) { return __fdividef(x, 1.f + __expf(-x)); }

struct PrepMeta { int l, K, n0, k0; size_t woff; };
__device__ __forceinline__ void prep_load(const KP& p, int job, int tid, float (&v)[8], PrepMeta& m) {
  int l = job / 5440, j = job % 5440;
  int mat, nt, kt, K; size_t woff;
  const float *s0, *s1, *sc; int ldn; float cs;
  if (j < 1408) { mat = 0; nt = j / 16; kt = j % 16; K = DM; woff = W_GUA; s0 = p.in[7] + (size_t)l * DM * DFF; s1 = p.in[8] + (size_t)l * DM * DFF; sc = p.in[6] + l * DM; ldn = DFF; cs = 1.f; }
  else if (j < 2112) { j -= 1408; mat = 1; nt = j / 44; kt = j % 44; K = DFF; woff = W_DA; s0 = s1 = p.in[9] + (size_t)l * DFF * DM; sc = nullptr; ldn = DM; cs = 0.5f; }
  else if (j < 3072) { j -= 2112; mat = 2; nt = j / 16; kt = j % 16; K = DM; woff = W_IN; s0 = s1 = p.in[11] + (size_t)l * DM * 3592; sc = p.in[10] + l * DM; ldn = 3592; cs = 1.f; }
  else if (j < 3328) { j -= 3072; mat = 3; nt = j / 16; kt = j % 16; K = DM; woff = W_OUT; s0 = s1 = p.in[20] + (size_t)l * DM * DM; sc = nullptr; ldn = DM; cs = 1.f; }
  else if (j < 4736) { j -= 3328; mat = 0; nt = j / 16; kt = j % 16; K = DM; woff = W_GUB; s0 = p.in[22] + (size_t)l * DM * DFF; s1 = p.in[23] + (size_t)l * DM * DFF; sc = p.in[21] + l * DM; ldn = DFF; cs = 1.f; }
  else { j -= 4736; mat = 1; nt = j / 44; kt = j % 44; K = DFF; woff = W_DB; s0 = s1 = p.in[24] + (size_t)l * DFF * DM; sc = nullptr; ldn = DM; cs = 0.5f; }
  const int n0 = nt * 64, k0 = kt * 64;
  m.l = l; m.K = K; m.n0 = n0; m.k0 = k0; m.woff = woff;
#pragma unroll
  for (int it = 0; it < 8; ++it) {
    int e = tid + 512 * it, kk = e >> 6, nn = e & 63;
    int k = k0 + kk, n = n0 + nn, c; bool ok = true; const float* sp = s0;
    const int nl = n & 255, bj = nl >> 7, wc_ = (nl >> 5) & 3, ns = (nl >> 4) & 1, r = nl & 15;
    if (mat == 0) { c = (n >> 8) * 128 + wc_ * 32 + (r >> 2) * 8 + bj * 4 + (r & 3); if (ns) sp = s1; }
    else {
      c = (n & ~255) + bj * 128 + wc_ * 32 + (r >> 2) * 8 + ns * 4 + (r & 3);
      if (mat == 2) { if (c < 1536) c = c; else if (c < 3584) c = c + 8; else if (c < 3592) c = 1536 + (c - 3584); else { ok = false; c = 0; } }
    }
    float x = sp[(size_t)k * ldn + c] * cs;
    if (sc) x *= sc[k];
    v[it] = ok ? x : 0.f;
  }
}
__device__ __forceinline__ void prep_tile_out(bfr* W, const float* tile, int tid, const float (&v)[8], const PrepMeta& m) {
#pragma unroll
  for (int it = 0; it < 8; ++it) { int e = tid + 512 * it; ((float*)tile)[(e >> 6) * 65 + (e & 63)] = v[it]; }
}
__device__ void phase_prep(const KP& p, int job_lo, int job_hi, int first_blk) {
  extern __shared__ __attribute__((aligned(16))) unsigned char smem[];
  int tid = threadIdx.x; asm volatile("" : "+v"(tid));
  bfr* W = (bfr*)(p.ws + OFF_W);
  const int total = (p.bid < first_blk) ? 0 : job_hi, stride = p.nblk - first_blk;
  float va[8], vb[8]; PrepMeta ma, mb;
  const int j0 = job_lo + (p.bid - first_blk);
  if (j0 < total) prep_load(p, j0, tid, va, ma);
  if (j0 + stride < total) prep_load(p, j0 + stride, tid, vb, mb);
  int buf = 0;
  for (int job = j0; job < total; job += 2 * stride) {
#pragma unroll
    for (int half = 0; half < 2; ++half) {
      const int jb = job + half * stride;
      if (jb < total) {
        float* tile = (float*)smem + buf * (64 * 65);
        PrepMeta mc = half ? mb : ma;
        if (half == 0) prep_tile_out(W, tile, tid, va, ma); else prep_tile_out(W, tile, tid, vb, mb);
        __syncthreads();
        if (jb + 2 * stride < total) { if (half == 0) prep_load(p, jb + 2 * stride, tid, va, ma); else prep_load(p, jb + 2 * stride, tid, vb, mb); }
        {
          int nn = tid >> 3, seg = tid & 7;
          u32x4 v;
          v[0] = pack2(tile[(seg * 8 + 0) * 65 + nn], tile[(seg * 8 + 1) * 65 + nn]);
          v[1] = pack2(tile[(seg * 8 + 2) * 65 + nn], tile[(seg * 8 + 3) * 65 + nn]);
          v[2] = pack2(tile[(seg * 8 + 4) * 65 + nn], tile[(seg * 8 + 5) * 65 + nn]);
          v[3] = pack2(tile[(seg * 8 + 6) * 65 + nn], tile[(seg * 8 + 7) * 65 + nn]);
          *(u32x4*)(W + (size_t)mc.l * W_LAYER + mc.woff + (size_t)(mc.n0 + nn) * mc.K + mc.k0 + seg * 8) = v;
        }
        buf ^= 1;
      }
    }
  }
  __syncthreads();
}

__device__ __forceinline__ float wave_sum(float v) {
#pragma unroll
  for (int o = 32; o >= 1; o >>= 1) v += __shfl_xor(v, o);
  return v;
}

__device__ void phase_init(const KP& p) {
  int tid_ = threadIdx.x; asm volatile("" : "+v"(tid_));
  const int lane = tid_ & 63, w = tid_ >> 6;
  bfr* hb = (bfr*)(p.ws + OFF_HB);
  float* rs = (float*)(p.ws + OFF_RS);
  for (int row = p.bid * 8 + w; row < T_ROWS; row += p.nblk * 8) {
    const float* src = nullptr;
    if (row < SROW0) {
      int s = row / PROW, pos = row % PROW;
      if (pos < 16) src = p.in[5] + (size_t)pos * DM;
      else if (pos < PLEN) src = p.in[0] + ((size_t)s * 4096 + (pos - 16)) * DM;
    } else src = p.in[1] + (size_t)(row - SROW0) * DM;
    float ss = 0.f;
#pragma unroll
    for (int i = 0; i < 4; ++i) {
      int c = 4 * (lane + 64 * i);
      float4 v = src ? *(const float4*)(src + c) : make_float4(0.f, 0.f, 0.f, 0.f);
      bfr b0 = f2bf(v.x), b1 = f2bf(v.y), b2 = f2bf(v.z), b3 = f2bf(v.w);
      float r0 = bf2f(b0), r1 = bf2f(b1), r2 = bf2f(b2), r3 = bf2f(b3);
      ss += r0 * r0 + r1 * r1 + r2 * r2 + r3 * r3;
      uint2 o; o.x = (unsigned)b0 | ((unsigned)b1 << 16); o.y = (unsigned)b2 | ((unsigned)b3 << 16);
      *(uint2*)(hb + (size_t)row * DM + c) = o;
    }
    ss = wave_sum(ss);
    if (lane == 0) rs[row] = rsqrtf(ss * (1.f / DM) + EPSF);
  }
}

__device__ void phase_stat(const KP& p) {
  int tid_ = threadIdx.x; asm volatile("" : "+v"(tid_));
  const int lane = tid_ & 63, w = tid_ >> 6;
  const bfr* hb = (const bfr*)(p.ws + OFF_HB);
  float* rs = (float*)(p.ws + OFF_RS);
  for (int row = p.bid * 8 + w; row < T_ROWS; row += p.nblk * 8) {
    float ss = 0.f;
#pragma unroll
    for (int i = 0; i < 2; ++i) {
      u32x4 v = *(const u32x4*)(hb + (size_t)row * DM + lane * 8 + 512 * i);
#pragma unroll
      for (int e = 0; e < 4; ++e) {
        float a = __uint_as_float(v[e] << 16), b = __uint_as_float(v[e] & 0xffff0000u);
        ss += a * a + b * b;
      }
    }
    ss = wave_sum(ss);
    if (lane == 0) rs[row] = rsqrtf(ss * (1.f / DM) + EPSF);
  }
}

__device__ void phase_final(const KP& p) {
  int tid_ = threadIdx.x; asm volatile("" : "+v"(tid_));
  const int lane = tid_ & 63, w = tid_ >> 6;
  const bfr* hb = (const bfr*)(p.ws + OFF_HB);
  const float* lw = p.in[25];
  for (int row = p.bid * 8 + w; row < T_ROWS; row += p.nblk * 8) {
    float* dst;
    if (row < SROW0) {
      int s = row / PROW, pos = row % PROW;
      if (pos < 16 || pos >= PLEN) continue;
      dst = p.out + O_YP + ((size_t)s * 4096 + (pos - 16)) * DM;
    } else dst = p.out + O_YS + (size_t)(row - SROW0) * DM;
    float x[16];
    float ss = 0.f;
#pragma unroll
    for (int i = 0; i < 2; ++i) {
      u32x4 v = *(const u32x4*)(hb + (size_t)row * DM + lane * 8 + 512 * i);
#pragma unroll
      for (int e = 0; e < 4; ++e) {
        float a = __uint_as_float(v[e] << 16), b = __uint_as_float(v[e] & 0xffff0000u);
        x[i * 8 + e * 2] = a; x[i * 8 + e * 2 + 1] = b;
        ss += a * a + b * b;
      }
    }
    ss = wave_sum(ss);
    float r = rsqrtf(ss * (1.f / DM) + EPSF);
#pragma unroll
    for (int i = 0; i < 2; ++i) {
      int c = lane * 8 + 512 * i;
      float4 w0 = *(const float4*)(lw + c), w1 = *(const float4*)(lw + c + 4);
      float4 o0 = make_float4(x[i * 8 + 0] * r * w0.x, x[i * 8 + 1] * r * w0.y, x[i * 8 + 2] * r * w0.z, x[i * 8 + 3] * r * w0.w);
      float4 o1 = make_float4(x[i * 8 + 4] * r * w1.x, x[i * 8 + 5] * r * w1.y, x[i * 8 + 6] * r * w1.z, x[i * 8 + 7] * r * w1.w);
      *(float4*)(dst + c) = o0; *(float4*)(dst + c + 4) = o1;
    }
  }
}

__device__ void phase_mixnorm(const KP& p, int l) {
  int tid_ = threadIdx.x; asm volatile("" : "+v"(tid_));
  const int lane = tid_ & 63, w = tid_ >> 6;
  bfr* mix = (bfr*)(p.ws + OFF_MIX);
  const bfr* proj = (const bfr*)(p.ws + OFF_U);
  for (int row = p.bid * 8 + w; row < T_ROWS; row += p.nblk * 8) {
    bfr* mp = mix + (size_t)row * DM + lane * 16;
    u32x4 v0 = *(const u32x4*)mp, v1 = *(const u32x4*)(mp + 8);
    float x[16];
#pragma unroll
    for (int e = 0; e < 4; ++e) {
      x[e * 2] = __uint_as_float(v0[e] << 16); x[e * 2 + 1] = __uint_as_float(v0[e] & 0xffff0000u);
      x[8 + e * 2] = __uint_as_float(v1[e] << 16); x[8 + e * 2 + 1] = __uint_as_float(v1[e] & 0xffff0000u);
    }
    float ss = 0.f;
#pragma unroll
    for (int e = 0; e < 16; ++e) ss += x[e] * x[e];
    ss += __shfl_xor(ss, 1); ss += __shfl_xor(ss, 2); ss += __shfl_xor(ss, 4);
    float s8 = __shfl_xor(ss, 8);
    float r;
    if (lane < 32) r = rsqrtf((ss + s8) * (1.f / 256.f) + EPSF);
    else r = rsqrtf(ss * (1.f / 128.f) + EPSF);
    float o[16];
    if (lane < 32) {
      const float* nw = p.in[17] + l * 512 + lane * 16;
#pragma unroll
      for (int e = 0; e < 16; ++e) o[e] = x[e] * r * nw[e];
    } else {
      int cg0 = (lane - 32) * 16;
      const float* nw = p.in[19] + l * 512 + cg0;
      const bfr* gp = proj + (size_t)row * NIN + 3072 + cg0;
      u32x4 g0 = *(const u32x4*)gp, g1 = *(const u32x4*)(gp + 8);
      float g[16];
#pragma unroll
      for (int e = 0; e < 4; ++e) {
        g[e * 2] = __uint_as_float(g0[e] << 16); g[e * 2 + 1] = __uint_as_float(g0[e] & 0xffff0000u);
        g[8 + e * 2] = __uint_as_float(g1[e] << 16); g[8 + e * 2 + 1] = __uint_as_float(g1[e] & 0xffff0000u);
      }
#pragma unroll
      for (int e = 0; e < 16; ++e) o[e] = x[e] * r * nw[e] * siluf(g[e]);
    }
    u32x4 w0, w1;
#pragma unroll
    for (int e = 0; e < 4; ++e) { w0[e] = pack2(o[e * 2], o[e * 2 + 1]); w1[e] = pack2(o[8 + e * 2], o[8 + e * 2 + 1]); }
    *(u32x4*)mp = w0; *(u32x4*)(mp + 8) = w1;
  }
}

constexpr int BM = 256, BK = 64, HALF = 128, NXCD = 8, WGM = 8, HT = HALF * BK;

__device__ __forceinline__ int lds_byte(int r, int c) {
  int st = (r >> 4) * 2 + (c >> 5), rr = r & 15, cc = c & 31, ob = rr * 64 + cc * 2;
  return st * 1024 + (ob ^ (((ob >> 9) & 1) << 5));
}
__device__ __forceinline__ void stage_rc(int b, int& R, int& C) {
  int st = b / 1024, sb = b % 1024, swz = sb ^ (((sb >> 9) & 1) << 5);
  R = (st >> 1) * 16 + swz / 64; C = (st & 1) * 32 + (swz % 64) / 2;
}

template <int EPI, int N, int K>
__device__ __forceinline__ void gemm_phase(const KP& p, int l, const bfr* A, const bfr* Bt) {
  extern __shared__ __attribute__((aligned(16))) unsigned char smem[];
  bfr* shm = (bfr*)smem;
#define SA(b, h) (shm + ((b) * 2 + (h)) * HT)
#define SB(b, h) (shm + (4 + (b) * 2 + (h)) * HT)
#define STAGE_B(P, BASE, br, kt) do { const char* _gb = (const char*)((BASE) + (long)(br) * K + (long)(kt) * BK); \
    unsigned _o0 = so0, _o1 = so1; asm volatile("" : "+v"(_o0), "+v"(_o1)); \
    __builtin_amdgcn_global_load_lds((const unsigned*)(_gb + _o0), (unsigned*)((char*)(P) + tid * 16), 16, 0, 0); \
    __builtin_amdgcn_global_load_lds((const unsigned*)(_gb + _o1), (unsigned*)((char*)(P) + tid * 16 + 8192), 16, 0, 0); } while (0)
#define STAGE_A(P, BASE, br, kt) STAGE_B(P, BASE, br, kt)
#define LDA(dst, b, h) for (int m = 0; m < 4; ++m) for (int k = 0; k < 2; ++k) \
    dst[m][k] = *reinterpret_cast<const bf16x8*>((char*)SA(b, h) + lds_byte(wr * 64 + m * 16 + fr, k * 32 + fq * 8))
#define LDB(dst, b, h) for (int n = 0; n < 2; ++n) for (int k = 0; k < 2; ++k) \
    dst[n][k] = *reinterpret_cast<const bf16x8*>((char*)SB(b, h) + lds_byte(wc * 32 + n * 16 + fr, k * 32 + fq * 8))
#define MMA(ai, bj, At, Bq) do { __builtin_amdgcn_s_setprio(1); \
    for (int m = 0; m < 4; ++m) for (int n = 0; n < 2; ++n) for (int k = 0; k < 2; ++k) \
      acc[ai][bj][m][n] = __builtin_amdgcn_mfma_f32_16x16x32_bf16(Bq[n][k], At[m][k], acc[ai][bj][m][n], 0, 0, 0); \
    __builtin_amdgcn_s_setprio(0); } while (0)
#define WAIT_V(n) asm volatile("s_waitcnt vmcnt(" #n ")" ::: "memory")
#define WAIT_L(n) asm volatile("s_waitcnt lgkmcnt(" #n ")" ::: "memory")
#define BAR __builtin_amdgcn_s_barrier()
#define SCHED __builtin_amdgcn_sched_barrier(0)

  constexpr int TM = 256, HM = 128;
  const int nM = T_ROWS / TM, nN = N / BM, nwg = nM * nN;
  int tid = threadIdx.x; asm volatile("" : "+v"(tid));
  const int wid = tid >> 6, lane = tid & 63, wr = wid >> 2, wc = wid & 3, fr = lane & 15, fq = lane >> 4;
  const int nt = K / BK;
  unsigned so0, so1;
  { int _r, _c; stage_rc(tid * 16, _r, _c); so0 = (unsigned)(_r * K + _c) * 2u; stage_rc(tid * 16 + 8192, _r, _c); so1 = (unsigned)(_r * K + _c) * 2u; }
#define TILE_COORDS(LT, BROW, BCOL, PN) do { int wgid = (LT); \
    { int q = nwg / NXCD, r = nwg % NXCD, xcd = wgid % NXCD, off = wgid / NXCD; \
      wgid = (xcd < r ? xcd * (q + 1) : r * (q + 1) + (xcd - r) * q) + off; } \
    int nig = WGM * nN, gid = wgid / nig, fm = gid * WGM, gsz = min(nM - fm, WGM); \
    int pm_ = fm + ((wgid % nig) % gsz); PN = (wgid % nig) / gsz; BROW = pm_ * TM; BCOL = PN * BM; } while (0)
  int brow = 0, bcol = 0, pn = 0;
  if (p.bid < nwg) {
    TILE_COORDS(p.bid, brow, bcol, pn);
    STAGE_B(SB(0, 0), Bt, bcol, 0); STAGE_A(SA(0, 0), A, brow, 0);
    STAGE_B(SB(0, 1), Bt, bcol + HALF, 0); STAGE_A(SA(0, 1), A, brow + HM, 0);
  }
  for (int Lt = p.bid; Lt < nwg; Lt += p.nblk) {
    f32x4 acc[2][2][4][2];
#pragma unroll
    for (int a = 0; a < 2; ++a)
#pragma unroll
      for (int b = 0; b < 2; ++b)
#pragma unroll
        for (int m = 0; m < 4; ++m)
#pragma unroll
          for (int n = 0; n < 2; ++n) acc[a][b][m][n] = f32x4{0.f, 0.f, 0.f, 0.f};
    bf16x8 At[4][2], B0[2][2], B1[2][2];
    if (wr == 1) BAR;
    WAIT_V(4); BAR;
    STAGE_B(SB(1, 0), Bt, bcol, 1); STAGE_A(SA(1, 0), A, brow, 1); STAGE_B(SB(1, 1), Bt, bcol + HALF, 1);
    WAIT_V(6); BAR;
    for (int t = 0; t < nt - 2; t += 2) {
      LDB(B0, 0, 0); SCHED; LDA(At, 0, 0); STAGE_A(SA(1, 1), A, brow + HM, t + 1);
      WAIT_L(8); BAR; WAIT_L(0); MMA(0, 0, At, B0); BAR; SCHED;
      LDB(B1, 0, 1); STAGE_B(SB(0, 0), Bt, bcol, t + 2);
      BAR; WAIT_L(0); MMA(0, 1, At, B1); BAR;
      LDA(At, 0, 1); STAGE_A(SA(0, 0), A, brow, t + 2);
      BAR; WAIT_L(0); MMA(1, 0, At, B0); BAR; SCHED;
      STAGE_B(SB(0, 1), Bt, bcol + HALF, t + 2);
      WAIT_V(6); BAR; MMA(1, 1, At, B1); BAR;
      LDB(B0, 1, 0); SCHED; LDA(At, 1, 0); STAGE_A(SA(0, 1), A, brow + HM, t + 2);
      WAIT_L(8); BAR; WAIT_L(0); MMA(0, 0, At, B0); BAR; SCHED;
      LDB(B1, 1, 1); STAGE_B(SB(1, 0), Bt, bcol, t + 3);
      BAR; WAIT_L(0); MMA(0, 1, At, B1); BAR;
      LDA(At, 1, 1); STAGE_A(SA(1, 0), A, brow, t + 3);
      BAR; WAIT_L(0); MMA(1, 0, At, B0); BAR; SCHED;
      STAGE_B(SB(1, 1), Bt, bcol + HALF, t + 3);
      WAIT_V(6); BAR; MMA(1, 1, At, B1); BAR;
    }
    { LDB(B0, 0, 0); LDA(At, 0, 0); STAGE_A(SA(1, 1), A, brow + HM, nt - 1);
      BAR; WAIT_L(0); MMA(0, 0, At, B0); BAR;
      LDB(B1, 0, 1); BAR; WAIT_L(0); MMA(0, 1, At, B1); BAR;
      LDA(At, 0, 1); WAIT_V(4); BAR; WAIT_L(0); MMA(1, 0, At, B0); MMA(1, 1, At, B1); BAR; }
    { LDB(B0, 1, 0); LDA(At, 1, 0); WAIT_V(2); BAR; WAIT_L(0); MMA(0, 0, At, B0); BAR;
      LDB(B1, 1, 1); WAIT_V(0); BAR; WAIT_L(0); MMA(0, 1, At, B1); BAR;
      LDA(At, 1, 1); BAR; WAIT_L(0); MMA(1, 0, At, B0); MMA(1, 1, At, B1); BAR; }
    if (wr == 0) BAR;
    const int erow = brow, ecol = bcol, epn = pn;
    if (Lt + p.nblk < nwg) {
      TILE_COORDS(Lt + p.nblk, brow, bcol, pn);
      STAGE_B(SB(0, 0), Bt, bcol, 0); STAGE_A(SA(0, 0), A, brow, 0);
      STAGE_B(SB(0, 1), Bt, bcol + HALF, 0); STAGE_A(SA(0, 1), A, brow + HM, 0);
    }

    const float* rs = (const float*)(p.ws + OFF_RS);
    if (EPI == 1) {
      bfr* act = (bfr*)(p.ws + OFF_U);
#pragma unroll
      for (int ai = 0; ai < 2; ++ai)
#pragma unroll
        for (int m = 0; m < 4; ++m) {
          int row = erow + ai * HM + wr * 64 + m * 16 + fr;
          const float r = rs[row];
          const float nrl = -1.44269504f * r, r2 = r * r;
          u32x4 pk;
#pragma unroll
          for (int bj = 0; bj < 2; ++bj)
#pragma unroll
            for (int jj = 0; jj < 2; ++jj) {
              f32v2_t g2 = {acc[ai][bj][m][0][2 * jj], acc[ai][bj][m][0][2 * jj + 1]};
              f32v2_t u2 = {acc[ai][bj][m][1][2 * jj], acc[ai][bj][m][1][2 * jj + 1]};
              f32v2_t t2 = g2 * nrl;
              f32v2_t e2 = {__builtin_amdgcn_exp2f(t2.x), __builtin_amdgcn_exp2f(t2.y)};
              f32v2_t d2 = e2 + 1.0f;
              f32v2_t rc = {__builtin_amdgcn_rcpf(d2.x), __builtin_amdgcn_rcpf(d2.y)};
              f32v2_t o2 = (g2 * u2) * r2 * rc;
              pk[bj * 2 + jj] = pack2(o2.x, o2.y);
            }
          *(u32x4*)(act + (size_t)row * DFF + (ecol >> 1) + wc * 32 + fq * 8) = pk;
        }
    } else if (EPI == 2) {
      bfr* hb = (bfr*)(p.ws + OFF_HB);
#pragma unroll
      for (int ai = 0; ai < 2; ++ai)
#pragma unroll
        for (int m = 0; m < 4; ++m) {
          int row = erow + ai * HM + wr * 64 + m * 16 + fr;
#pragma unroll
          for (int bj = 0; bj < 2; ++bj) {
            u32x4* hp = (u32x4*)(hb + (size_t)row * DM + ecol + bj * HALF + wc * 32 + fq * 8);
            u32x4 h = *hp, o;
#pragma unroll
            for (int q2 = 0; q2 < 4; ++q2) {
              f32v2_t hv2 = {__uint_as_float(h[q2] << 16), __uint_as_float(h[q2] & 0xffff0000u)};
              f32v2_t av2 = {acc[ai][bj][m][q2 >> 1][(q2 & 1) * 2], acc[ai][bj][m][q2 >> 1][(q2 & 1) * 2 + 1]};
              f32v2_t s2 = hv2 + av2;
              o[q2] = pack2(s2.x, s2.y);
            }
            *hp = o;
          }
        }
    } else {
      bfr* proj = (bfr*)(p.ws + OFF_U);
      float* dtb = (float*)(p.ws + OFF_DT);
#pragma unroll
      for (int ai = 0; ai < 2; ++ai)
#pragma unroll
        for (int m = 0; m < 4; ++m) {
          int row = erow + ai * HM + wr * 64 + m * 16 + fr;
          float r = rs[row];
          if (epn < 14) {
            float* cdst = nullptr;
            bfr* tdst = nullptr;
            if (ecol >= 512 && ecol < 1536) {
              { int cid, tl;
                if (row < SROW0) { int s = row / PROW, pos = row % PROW; cid = s * 65 + (pos >> 6); tl = (pos & 63) - 61; }
                else { int rr = row - SROW0; cid = 520 + (rr >> 6); tl = (rr & 63) - 61; }
                if (tl >= 0) tdst = (bfr*)(p.ws + OFF_TAILS) + ((size_t)cid * 3 + tl) * 1024; }
              if (row < SROW0) { int s = row / PROW, tl = row % PROW - (PLEN - 3); if (tl >= 0 && tl < 3) cdst = p.out + O_CP + ((size_t)(l * 8 + s) * 3 + tl) * 1024; }
              else { int s = (row - SROW0) >> 6, tl = ((row - SROW0) & 63) - 61; if (tl >= 0) cdst = p.out + O_CS + ((size_t)(l * 8 + s) * 3 + tl) * 1024; }
            }
#pragma unroll
            for (int bj = 0; bj < 2; ++bj) {
              int col = ecol + bj * HALF + wc * 32 + fq * 8;
              float v[8];
#pragma unroll
              for (int n = 0; n < 2; ++n)
#pragma unroll
                for (int jj = 0; jj < 2; ++jj) {
                  f32v2_t t2 = f32v2_t{acc[ai][bj][m][n][2 * jj], acc[ai][bj][m][n][2 * jj + 1]} * r;
                  v[n * 4 + 2 * jj] = t2.x; v[n * 4 + 2 * jj + 1] = t2.y;
                }
              u32x4 pk; pk[0] = pack2(v[0], v[1]); pk[1] = pack2(v[2], v[3]); pk[2] = pack2(v[4], v[5]); pk[3] = pack2(v[6], v[7]);
              *(u32x4*)(proj + (size_t)row * NIN + col) = pk;
              if (cdst) { *(float4*)(cdst + col - 512) = make_float4(v[0], v[1], v[2], v[3]); *(float4*)(cdst + col - 512 + 4) = make_float4(v[4], v[5], v[6], v[7]); }
              if (tdst) *(u32x4*)(tdst + col - 512) = pk;
            }
          } else {
            if (wc == 0 && fq == 0) {
              *(float4*)(dtb + (size_t)row * 8) = make_float4(acc[ai][0][m][0][0] * r, acc[ai][0][m][0][1] * r, acc[ai][0][m][0][2] * r, acc[ai][0][m][0][3] * r);
              *(float4*)(dtb + (size_t)row * 8 + 4) = make_float4(acc[ai][0][m][1][0] * r, acc[ai][0][m][1][1] * r, acc[ai][0][m][1][2] * r, acc[ai][0][m][1][3] * r);
            }
          }
        }
    }
  }
#undef SA
#undef TILE_COORDS
#undef SB
#undef STAGE_A
#undef STAGE_B
#undef LDA
#undef LDB
#undef MMA
}

__device__ __forceinline__ f32x4 mma_lds(const bfr* A, int lda, const bfr* B, int ldb, int ksteps, f32x4 acc, int fr, int fq) {
  for (int ks = 0; ks < ksteps; ++ks) {
    bf16x8 a = *(const bf16x8*)(A + fr * lda + ks * 32 + fq * 8);
    bf16x8 b = *(const bf16x8*)(B + fr * ldb + ks * 32 + fq * 8);
    acc = __builtin_amdgcn_mfma_f32_16x16x32_bf16(a, b, acc, 0, 0, 0);
  }
  return acc;
}

__device__ __forceinline__ f32x4 mma_gl(const bf16x8* af, const bfr* B, int ldb, int ksteps, f32x4 acc, int fr, int fq) {
  bf16x8 b0 = *(const bf16x8*)(B + fr * ldb + 0 * 32 + fq * 8);
  bf16x8 b1 = *(const bf16x8*)(B + fr * ldb + 1 * 32 + fq * 8);
  bf16x8 b2 = *(const bf16x8*)(B + fr * ldb + 2 * 32 + fq * 8);
  bf16x8 b3 = *(const bf16x8*)(B + fr * ldb + 3 * 32 + fq * 8);
  f32x4 c0 = acc, c1 = f32x4{0.f, 0.f, 0.f, 0.f};
  c0 = __builtin_amdgcn_mfma_f32_16x16x32_bf16(af[0], b0, c0, 0, 0, 0);
  c1 = __builtin_amdgcn_mfma_f32_16x16x32_bf16(af[1], b1, c1, 0, 0, 0);
  c0 = __builtin_amdgcn_mfma_f32_16x16x32_bf16(af[2], b2, c0, 0, 0, 0);
  c1 = __builtin_amdgcn_mfma_f32_16x16x32_bf16(af[3], b3, c1, 0, 0, 0);
  (void)ksteps;
  return c0 + c1;
}

__device__ void ssd_pre(const KP& p, int l, int cid, int g) {
  extern __shared__ __attribute__((aligned(16))) unsigned char smem[];
  int tid_ = threadIdx.x; asm volatile("" : "+v"(tid_));
  const int tid = tid_, w = tid >> 6, lane = tid & 63, fr = lane & 15, fq = lane >> 4;
  bfr* Cs = (bfr*)smem;
  bfr* Bs = Cs + 64 * 136;
  bfr* BTs = Bs + 64 * 136;
  bfr* xTs = BTs + 128 * 72;
  bfr* Gs = xTs + 256 * 72;
  float* dtv = (float*)(Gs + 64 * 72);
  float* cumv = dtv + 256;
  float* ev = cumv + 256;

  bool prompt, first; int r0, pos0, len, sb = 0;
  if (cid < 520) { int s = cid / 65, c = cid % 65; prompt = true; first = (c == 0); r0 = s * PROW + c * 64; pos0 = c * 64; len = PLEN; }
  else { sb = cid - 520; prompt = false; first = true; r0 = SROW0 + sb * 64; pos0 = 0; len = 64; }
  bfr* proj = (bfr*)(p.ws + OFF_U);
  float* dtbuf = (float*)(p.ws + OFF_DT);
  bfr* mix = (bfr*)(p.ws + OFF_MIX);
  const bfr* tails = (const bfr*)(p.ws + OFF_TAILS);
  const float* convw = p.in[12] + (size_t)l * 4 * 1024;
  const float* convb = p.in[13] + (size_t)l * 1024;

  if (tid < 256) {
    int hh = tid >> 6, i = tid & 63, h = g * 4 + hh;
    float x = dtbuf[(size_t)(r0 + i) * 8 + h] + p.in[14][l * 8 + h];
    float dt = (x > 20.f) ? x : __logf(1.f + __expf(x));
    if (pos0 + i >= len) dt = 0.f;
    float cum = dt * (-__expf(p.in[15][l * 8 + h]));
#pragma unroll
    for (int o = 1; o < 64; o <<= 1) { float t = __shfl_up(cum, o); if (i >= o) cum += t; }
    float cl = __shfl(cum, 63);
    dtv[tid] = dt; cumv[tid] = cum; ev[tid] = dt * __expf(cl - cum);
    dtbuf[(size_t)(r0 + i) * 8 + h] = cum;
  }
  {
    const int item = tid;
    const int pair = item & 255, half_ = item >> 8, cc0 = pair * 2;
    const int rs_ = half_ * 32, re_ = rs_ + 32;
    const int ch = (cc0 < 256) ? (g * 256 + cc0) : ((cc0 < 384) ? (512 + g * 128 + cc0 - 256) : (768 + g * 128 + cc0 - 384));
    float w0[5], w1[5];
#pragma unroll
    for (int k = 0; k < 4; ++k) { w0[k] = convw[k * 1024 + ch]; w1[k] = convw[k * 1024 + ch + 1]; }
    w0[4] = convb[ch]; w1[4] = convb[ch + 1];
    float a0[3], a1[3];
#pragma unroll
    for (int k = 0; k < 3; ++k) {
      int rr = rs_ - 3 + k;
      float x0 = 0.f, x1 = 0.f;
      if (rr >= 0) { unsigned u = *(const unsigned*)(proj + (size_t)(r0 + rr) * NIN + 512 + ch); x0 = __uint_as_float(u << 16); x1 = __uint_as_float(u & 0xffff0000u); }
      else if (!first) { unsigned u = *(const unsigned*)(tails + ((size_t)(cid - 1) * 3 + (rr + 3)) * 1024 + ch); x0 = __uint_as_float(u << 16); x1 = __uint_as_float(u & 0xffff0000u); }
      else if (!prompt) { const float* sp = p.in[2] + (((size_t)l * 8 + sb) * 3 + (rr + 3)) * 1024 + ch; x0 = bf2f(f2bf(sp[0])); x1 = bf2f(f2bf(sp[1])); }
      a0[k] = x0; a1[k] = x1;
    }
    f32v2_t wv[5], av[3];
#pragma unroll
    for (int k = 0; k < 5; ++k) wv[k] = f32v2_t{w0[k], w1[k]};
#pragma unroll
    for (int k = 0; k < 3; ++k) av[k] = f32v2_t{a0[k], a1[k]};
    const bfr* gp = proj + (size_t)r0 * NIN + 512 + ch;
    int nin_ = NIN; asm volatile("" : "+s"(nin_));
    unsigned ur[32];
#pragma unroll
    for (int k = 0; k < 32; ++k) { int i = rs_ + k; ur[k] = *(const unsigned*)(gp + (size_t)i * nin_); }
#pragma unroll
    for (int k = 0; k < 32; ++k) {
      const int i = rs_ + k;
      if (i < re_) {
        unsigned u = ur[k];
        float x0 = __uint_as_float(u << 16), x1 = __uint_as_float(u & 0xffff0000u);
        f32v2_t xv = {x0, x1};
        f32v2_t vv = wv[4] + av[0] * wv[0] + av[1] * wv[1] + av[2] * wv[2] + xv * wv[3];
        av[0] = av[1]; av[1] = av[2]; av[2] = xv;
        f32v2_t tv = vv * -1.44269504f;
        f32v2_t ev = {__builtin_amdgcn_exp2f(tv.x), __builtin_amdgcn_exp2f(tv.y)};
        f32v2_t dv = ev + 1.0f;
        f32v2_t rv = {__builtin_amdgcn_rcpf(dv.x), __builtin_amdgcn_rcpf(dv.y)};
        vv = vv * rv;
        float v0 = vv.x, v1 = vv.y;
        if (cc0 < 256) { xTs[cc0 * 72 + i] = f2bf(v0); xTs[(cc0 + 1) * 72 + i] = f2bf(v1); }
        else if (cc0 < 384) {
          int n = cc0 - 256; unsigned pk = pack2(v0, v1);
          *(unsigned*)(Bs + i * 136 + n) = pk;
          BTs[n * 72 + i] = (bfr)(pk & 0xffffu); BTs[(n + 1) * 72 + i] = (bfr)(pk >> 16);
        } else *(unsigned*)(Cs + i * 136 + (cc0 - 384)) = pack2(v0, v1);
      }
    }
  }
  __syncthreads();
  f32x4 cb[2];
#pragma unroll
  for (int q = 0; q < 2; ++q) {
    int t = w * 2 + q, ti = t >> 2, tj = t & 3;
    cb[q] = f32x4{0.f, 0.f, 0.f, 0.f};
    if (tj <= ti) cb[q] = mma_lds(Cs + ti * 16 * 136, 136, Bs + tj * 16 * 136, 136, 4, cb[q], fr, fq);
  }
#pragma unroll
  for (int it = 0; it < 2; ++it) {
    int e = tid + 512 * it;
    { int i = e >> 4, sg = e & 15; *(u32x4*)(proj + (size_t)(r0 + i) * NIN + 1280 + g * 128 + sg * 8) = *(const u32x4*)(Cs + i * 136 + sg * 8); }
    { int n = e >> 3, sg = e & 7; *(u32x4*)(proj + (size_t)(r0 + (n >> 1)) * NIN + 1024 + g * 128 + (n & 1) * 64 + sg * 8) = *(const u32x4*)(BTs + n * 72 + sg * 8); }
  }
#pragma unroll
  for (int it = 0; it < 4; ++it) {
    int e = tid + 512 * it, xr = e >> 3, sg = e & 7, hh = xr >> 6, pp = xr & 63;
    u32x4 v = *(const u32x4*)(xTs + xr * 72 + sg * 8), o;
#pragma unroll
    for (int k = 0; k < 4; ++k) {
      float e0 = ev[hh * 64 + sg * 8 + 2 * k], e1 = ev[hh * 64 + sg * 8 + 2 * k + 1];
      o[k] = pack2(__uint_as_float(v[k] << 16) * e0, __uint_as_float(v[k] & 0xffff0000u) * e1);
    }
    *(u32x4*)(proj + (size_t)(r0 + pp) * NIN + 512 + (g * 4 + hh) * 64 + sg * 8) = o;
  }
  for (int hh = 0; hh < 4; ++hh) {
    const int h = g * 4 + hh;
    const float Dh = p.in[16][l * 8 + h];
#pragma unroll
    for (int q = 0; q < 2; ++q) {
      int t = w * 2 + q, ti = t >> 2, tj = t & 3, jx = tj * 16 + fr;
      float cj = cumv[hh * 64 + jx], dj = dtv[hh * 64 + jx];
#pragma unroll
      for (int j = 0; j < 4; ++j) {
        int i = ti * 16 + fq * 4 + j;
        float gv = (tj <= ti && jx <= i) ? cb[q][j] * __expf(cumv[hh * 64 + i] - cj) * dj : 0.f;
        Gs[i * 72 + jx] = f2bf(gv);
      }
    }
    __syncthreads();
#pragma unroll
    for (int q = 0; q < 2; ++q) {
      int t = w * 2 + q, ti = t >> 2, tp = t & 3;
      f32x4 a = f32x4{0.f, 0.f, 0.f, 0.f};
      a = mma_lds(Gs + ti * 16 * 72, 72, xTs + (hh * 64 + tp * 16) * 72, 72, 2, a, fr, fq);
      int pp = tp * 16 + fr;
#pragma unroll
      for (int j = 0; j < 4; ++j) {
        int i = ti * 16 + fq * 4 + j;
        float y = a[j] + Dh * bf2f(xTs[(hh * 64 + pp) * 72 + i]);
        mix[(size_t)(r0 + i) * DM + h * 64 + pp] = f2bf(y);
      }
    }
    __syncthreads();
  }
}

__device__ __forceinline__ void store_bf16_asm(bfr* addr, unsigned v) { asm volatile("global_store_short %0, %1, off" :: "v"(addr), "v"(v) : "memory"); }

__device__ void ssd_seq(const KP& p, int l, int s, int h, int ph) {
  extern __shared__ __attribute__((aligned(16))) unsigned char smem[];
  int tid_ = threadIdx.x; asm volatile("" : "+v"(tid_));
  const int tid = tid_, w = tid >> 6, lane = tid & 63, fr = lane & 15, fq = lane >> 4;
  bfr* Sbs = (bfr*)smem;
  const bool prompt = s < 8;
  const int sb = s & 7;
  const int row0 = prompt ? s * PROW : SROW0 + sb * 64;
  const int nch = prompt ? 65 : 1, len = prompt ? PLEN : 64;
  const int g = h >> 2;
  const bfr* proj = (const bfr*)(p.ws + OFF_U);
  const float* cumb = (const float*)(p.ws + OFF_DT);
  bfr* mix = (bfr*)(p.ws + OFF_MIX);
  const int ti = w >> 1, tp = w & 1;
  const int zc = h * 64 + ph * 32 + tp * 16 + fr;

  f32x4 Sacc[2];
#pragma unroll
  for (int pt = 0; pt < 2; ++pt)
#pragma unroll
    for (int j = 0; j < 4; ++j) {
      int pp = pt * 16 + fq * 4 + j, n = 16 * w + fr;
      float v = 0.f;
      if (!prompt) v = p.in[3][((((size_t)l * 8 + sb) * 8 + h) * 64 + ph * 32 + pp) * 128 + n];
      Sacc[pt][j] = v;
      Sbs[pp * 136 + n] = f2bf(v);
    }
  __syncthreads();

  bf16x8 Cs_[2][4], Xs_[2][2][2], Bs_[2][2];
  bfr ys_[2][4], zs_[2][4]; float cus_[2][4], cls_[2];
  const int nB = 16 * w + fr;
#define LBAR() do { asm volatile("s_waitcnt lgkmcnt(0)" ::: "memory"); __builtin_amdgcn_s_barrier(); asm volatile("" ::: "memory"); } while (0)
  const unsigned coff = (unsigned)(((ti * 16 + fr) * NIN + 1280 + g * 128 + fq * 8) * 2);
  unsigned xoff[2];
#pragma unroll
  for (int pt = 0; pt < 2; ++pt) xoff[pt] = (unsigned)(((ph * 32 + pt * 16 + fr) * NIN + 512 + h * 64 + fq * 8) * 2);
  const unsigned boff = (unsigned)((((nB >> 1)) * NIN + 1024 + g * 128 + (nB & 1) * 64 + fq * 8) * 2);
  const unsigned zoff = (unsigned)(((ti * 16 + fq * 4) * NIN + zc) * 2);
  const unsigned yoff = (unsigned)(((ti * 16 + fq * 4) * DM + zc) * 2);
  const unsigned cuoff = (unsigned)(((ti * 16 + fq * 4) * 8 + h) * 4);
#define SSD_LOAD(SET, R0) do { const int _r0 = (R0); \
    const char* _pb = (const char*)proj + (size_t)_r0 * (NIN * 2); \
    const char* _mb = (const char*)mix + (size_t)_r0 * (DM * 2); \
    const char* _cb = (const char*)cumb + (size_t)_r0 * 32; \
    for (int ks = 0; ks < 4; ++ks) Cs_[SET][ks] = *(const bf16x8*)(_pb + coff + ks * 64); \
    for (int pt = 0; pt < 2; ++pt) for (int ks = 0; ks < 2; ++ks) Xs_[SET][pt][ks] = *(const bf16x8*)(_pb + xoff[pt] + ks * 64); \
    for (int ks = 0; ks < 2; ++ks) Bs_[SET][ks] = *(const bf16x8*)(_pb + boff + ks * 64); \
    for (int j = 0; j < 4; ++j) { ys_[SET][j] = *(const bfr*)(_mb + yoff + j * (DM * 2)); zs_[SET][j] = *(const bfr*)(_pb + zoff + j * (NIN * 2)); cus_[SET][j] = *(const float*)(_cb + cuoff + j * 32); } \
    cls_[SET] = *(const float*)(_cb + (63 * 8 + h) * 4); } while (0)
#define SSD_STEP(k, c) do { const int r0 = row0 + (c) * 64; \
    { f32x4 a2 = f32x4{0.f, 0.f, 0.f, 0.f}; \
      a2 = mma_gl(Cs_[k], Sbs + ((k) & 1) * (32 * 136) + tp * 16 * 136, 136, 4, a2, fr, fq); \
      for (int j = 0; j < 4; ++j) { \
        int i = ti * 16 + fq * 4 + j; \
        float y = bf2f(ys_[k][j]) + __expf(cus_[k][j]) * a2[j]; \
        float yz = y * siluf(bf2f(zs_[k][j])); \
        if ((c) * 64 + i >= len) yz = 0.f; \
        store_bf16_asm((bfr*)((char*)mix + (size_t)r0 * (DM * 2) + yoff + j * (DM * 2)), (unsigned)f2bf(yz)); \
      } } \
    { float dec = __expf(cls_[k]); \
      for (int pt = 0; pt < 2; ++pt) { \
        f32x4 a = Sacc[pt]; \
        a[0] *= dec; a[1] *= dec; a[2] *= dec; a[3] *= dec; \
        for (int ks = 0; ks < 2; ++ks) a = __builtin_amdgcn_mfma_f32_16x16x32_bf16(Xs_[k][pt][ks], Bs_[k][ks], a, 0, 0, 0); \
        Sacc[pt] = a; \
        for (int j = 0; j < 4; ++j) Sbs[(((k) + 1) & 1) * (32 * 136) + (pt * 16 + fq * 4 + j) * 136 + 16 * w + fr] = f2bf(a[j]); \
      } } } while (0)
#pragma unroll
  for (int k = 0; k < 2; ++k) SSD_LOAD(k, row0 + min(k, nch - 1) * 64);
  int c0 = 0;
  for (; c0 + 1 < nch; c0 += 2) {
#pragma unroll
    for (int k = 0; k < 2; ++k) {
      const int c = c0 + k;
      SSD_STEP(k, c);
      SSD_LOAD(k, row0 + min(c + 2, nch - 1) * 64);
      LBAR();
    }
  }
  if (c0 < nch) { SSD_STEP(0, c0); LBAR(); }
#undef SSD_STEP
#undef LBAR
#undef SSD_LOAD
  float* so = p.out + (prompt ? O_SP : O_SS) + (((size_t)l * 8 + sb) * 8 + h) * 64 * 128;
#pragma unroll
  for (int pt = 0; pt < 2; ++pt)
#pragma unroll
    for (int j = 0; j < 4; ++j) so[(size_t)(ph * 32 + pt * 16 + fq * 4 + j) * 128 + 16 * w + fr] = Sacc[pt][j];
}

__device__ __forceinline__ void gla_pre(const KP& p, int l, int sbid, int h, bfr (&qn)[8], bfr (&fn)[8], u32x4& vv, bool have, bool want_next) {
  extern __shared__ __attribute__((aligned(16))) unsigned char smem[];
  int tid_ = threadIdx.x; asm volatile("" : "+v"(tid_));
  const int tid = tid_, w = tid >> 6, lane = tid & 63, fr = lane & 15, fq = lane >> 4;
  bfr* qes = (bfr*)smem;
  bfr* kes = qes + 32 * 136;
  bfr* kdTs = kes + 32 * 136;
  bfr* vTs = kdTs + 128 * 40;
  bfr* atts = vTs + 128 * 40;
  float* segs = (float*)(atts + 32 * 40);

  int r0, pos0, len;
  if (sbid < 1040) { int s = sbid / 130, st = sbid % 130; r0 = s * PROW + st * 32; pos0 = st * 32; len = PLEN; }
  else { int x = sbid - 1040; r0 = SROW0 + x * 32; pos0 = (x & 1) * 32; len = 64; }
  bfr* proj = (bfr*)(p.ws + OFF_U);
  bfr* mix = (bfr*)(p.ws + OFF_MIX);
  float* decb = (float*)(p.ws + OFF_DEC);
  const int kk_ = tid & 127, seg = tid >> 7;
  float lb = 0.f;
  if (l == 1) {
    float d = p.in[18][512 + h * 128 + kk_] - p.in[18][h * 128 + kk_];
    lb = fminf(__fdividef(1.f, 1.f + __expf(-d)), 1.f - 1e-6f);
  }
  float qv[8], kv[8], cm[8];
#define GLAPRE_LOAD(H) do { \
    for (int it = 0; it < 8; ++it) { size_t rb = (size_t)(r0 + seg * 8 + it) * NIN; \
      qn[it] = proj[rb + 1536 + (H) * 128 + kk_]; fn[it] = proj[rb + 2048 + (H) * 128 + kk_]; } \
    { int j = tid >> 4, sg = tid & 15; vv = *(const u32x4*)(proj + (size_t)(r0 + j) * NIN + 2560 + (H) * 128 + sg * 8); } } while (0)
  if (!have) GLAPRE_LOAD(h);
  {
    float run = 0.f;
#pragma unroll
    for (int it = 0; it < 8; ++it) {
      int j = seg * 8 + it;
      float hq = bf2f(qn[it]), fx = bf2f(fn[it]);
      qv[it] = siluf(hq);
      float ex_ = __expf(fx);
      float sg_ = __fdividef(1.f, 1.f + ex_);
      float kkv = (1.f - lb) * sg_;
      float fsel = (kkv < 0.5f) ? (1.f - kkv) : fmaxf(lb + (1.f - lb) * ex_ * sg_, 1e-30f);
      float lf = __logf(fsel);
      if (pos0 + j >= len) { kkv = 0.f; lf = 0.f; }
      kv[it] = kkv;
      run += lf; cm[it] = run;
    }
    segs[seg * 128 + kk_] = run;
    { int j = tid >> 4, sg = tid & 15;
#pragma unroll
      for (int k = 0; k < 4; ++k) { vTs[(sg * 8 + 2 * k) * 40 + j] = (bfr)(vv[k] & 0xffffu); vTs[(sg * 8 + 2 * k + 1) * 40 + j] = (bfr)(vv[k] >> 16); } }
  }
  __syncthreads();
  if (want_next) GLAPRE_LOAD(h + 1);
#undef GLAPRE_LOAD
  {
    float s0 = segs[kk_], s1 = segs[128 + kk_], s2 = segs[256 + kk_], s3 = segs[384 + kk_];
    float base = (seg > 0 ? s0 : 0.f) + (seg > 1 ? s1 : 0.f) + (seg > 2 ? s2 : 0.f);
    float cl = s0 + s1 + s2 + s3;
    const float ecl = __expf(cl);
    if (seg == 0) decb[((size_t)sbid * 4 + h) * 128 + kk_] = ecl;
#pragma unroll
    for (int it = 0; it < 8; ++it) {
      int j = seg * 8 + it;
      float c = base + cm[it];
      float en = __expf(-c), kn = kv[it] * en;
      qes[j * 136 + kk_] = f2bf(qv[it] * __expf(c));
      kes[j * 136 + kk_] = f2bf(kn);
      kdTs[kk_ * 40 + j] = f2bf(kn * ecl);
    }
  }
  asm volatile("s_waitcnt lgkmcnt(0)" ::: "memory"); __builtin_amdgcn_s_barrier(); asm volatile("" ::: "memory");
  if (w < 4) {
    int ti = w >> 1, tj = w & 1;
    f32x4 a = f32x4{0.f, 0.f, 0.f, 0.f};
    if (tj <= ti) a = mma_lds(qes + ti * 16 * 136, 136, kes + tj * 16 * 136, 136, 4, a, fr, fq);
    int jx = tj * 16 + fr;
#pragma unroll
    for (int j = 0; j < 4; ++j) {
      int i = ti * 16 + fq * 4 + j;
      atts[i * 40 + jx] = f2bf((tj <= ti && jx <= i) ? a[j] : 0.f);
    }
  }
  { int j = tid >> 4, sg = tid & 15; *(u32x4*)(proj + (size_t)(r0 + j) * NIN + 1536 + h * 128 + sg * 8) = *(const u32x4*)(qes + j * 136 + sg * 8); }
  { int k = tid >> 2, sg = tid & 3;
    *(u32x4*)(proj + (size_t)(r0 + (k >> 2)) * NIN + 2048 + h * 128 + (k & 3) * 32 + sg * 8) = *(const u32x4*)(kdTs + k * 40 + sg * 8);
    *(u32x4*)(proj + (size_t)(r0 + (k >> 2)) * NIN + 2560 + h * 128 + (k & 3) * 32 + sg * 8) = *(const u32x4*)(vTs + k * 40 + sg * 8); }
  asm volatile("s_waitcnt lgkmcnt(0)" ::: "memory"); __builtin_amdgcn_s_barrier(); asm volatile("" ::: "memory");
#pragma unroll
  for (int q = 0; q < 2; ++q) {
    int t = w * 2 + q, ti = t >> 3, tv = t & 7;
    f32x4 a = f32x4{0.f, 0.f, 0.f, 0.f};
    a = mma_lds(atts + ti * 16 * 40, 40, vTs + tv * 16 * 40, 40, 1, a, fr, fq);
#pragma unroll
    for (int j = 0; j < 4; ++j) {
      int i = ti * 16 + fq * 4 + j;
      mix[(size_t)(r0 + i) * DM + 512 + h * 128 + tv * 16 + fr] = f2bf(a[j]);
    }
  }
  asm volatile("s_waitcnt lgkmcnt(0)" ::: "memory"); __builtin_amdgcn_s_barrier(); asm volatile("" ::: "memory");
}

__device__ void gla_seq(const KP& p, int l, int s, int h, int vq) {
  extern __shared__ __attribute__((aligned(16))) unsigned char smem[];
  int tid_ = threadIdx.x; asm volatile("" : "+v"(tid_));
  const int tid = tid_, w = tid >> 6, lane = tid & 63, fr = lane & 15, fq = lane >> 4;
  bfr* STs = (bfr*)smem;
  const bool prompt = s < 8;
  const int sb = s & 7;
  const int row0 = prompt ? s * PROW : SROW0 + sb * 64;
  const int nst = prompt ? 130 : 2, len = prompt ? PLEN : 64;
  const int sbid0 = prompt ? s * 130 : 1040 + sb * 2;
  const bfr* proj = (const bfr*)(p.ws + OFF_U);
  const float* decb = (const float*)(p.ws + OFF_DEC);
  bfr* mix = (bfr*)(p.ws + OFF_MIX);
  const int ti = (w >> 1) & 1, tv = w & 1;
  const int oc = 512 + h * 128 + vq * 32 + tv * 16 + fr;

  f32x4 Sacc[2];
#pragma unroll
  for (int vt = 0; vt < 2; ++vt)
#pragma unroll
    for (int j = 0; j < 4; ++j) {
      int k = 16 * w + fq * 4 + j, v = vt * 16 + fr;
      float x = 0.f;
      if (!prompt) x = p.in[4][((((size_t)l * 8 + sb) * 4 + h) * 128 + k) * 128 + vq * 32 + v];
      Sacc[vt][j] = x;
      STs[v * 136 + k] = f2bf(x);
    }
  __syncthreads();

  bf16x8 Qs[4][4], Ks[4], Vs[4][2];
  bfr os_[4][4]; float ds_[4][4];
  const int kA = 16 * w + fr;
#define LBAR() do { asm volatile("s_waitcnt lgkmcnt(0)" ::: "memory"); __builtin_amdgcn_s_barrier(); asm volatile("" ::: "memory"); } while (0)
  const unsigned qoff = (unsigned)(((ti * 16 + fr) * NIN + 1536 + h * 128 + fq * 8) * 2);
  const unsigned koff = (unsigned)((((kA >> 2)) * NIN + 2048 + h * 128 + (kA & 3) * 32 + fq * 8) * 2);
  unsigned voff[2];
#pragma unroll
  for (int vt = 0; vt < 2; ++vt) { int _v = vq * 32 + vt * 16 + fr; voff[vt] = (unsigned)(((_v >> 2) * NIN + 2560 + h * 128 + (_v & 3) * 32 + fq * 8) * 2); }
  const unsigned ooff = (unsigned)(((ti * 16 + fq * 4) * DM + oc) * 2);
  const unsigned doff = (unsigned)((h * 128 + 16 * w + fq * 4) * 4);
#define GLA_LOAD(SET, ST) do { const int _st = (ST); \
    const char* _pb = (const char*)proj + (size_t)(row0 + _st * 32) * (NIN * 2); \
    const char* _mb = (const char*)mix + (size_t)(row0 + _st * 32) * (DM * 2); \
    const char* _db = (const char*)decb + (size_t)(sbid0 + _st) * (4 * 128 * 4); \
    for (int ks = 0; ks < 4; ++ks) Qs[SET][ks] = *(const bf16x8*)(_pb + qoff + ks * 64); \
    for (int j = 0; j < 4; ++j) os_[SET][j] = *(const bfr*)(_mb + ooff + j * (DM * 2)); \
    Ks[SET] = *(const bf16x8*)(_pb + koff); \
    for (int vt = 0; vt < 2; ++vt) Vs[SET][vt] = *(const bf16x8*)(_pb + voff[vt]); \
    { const f32x4 _d = *(const f32x4*)(_db + doff); ds_[SET][0] = _d[0]; ds_[SET][1] = _d[1]; ds_[SET][2] = _d[2]; ds_[SET][3] = _d[3]; } } while (0)
#define GLA_STEP(k, st) do { const int r0 = row0 + (st) * 32; \
    if (w < 4) { \
      f32x4 a = f32x4{0.f, 0.f, 0.f, 0.f}; \
      a = mma_gl(Qs[k], STs + ((k) & 1) * (32 * 136) + tv * 16 * 136, 136, 4, a, fr, fq); \
      for (int j = 0; j < 4; ++j) { \
        int i = ti * 16 + fq * 4 + j; \
        float o = bf2f(os_[k][j]) + a[j]; \
        if ((st) * 32 + i >= len) o = 0.f; \
        store_bf16_asm((bfr*)((char*)mix + (size_t)r0 * (DM * 2) + ooff + j * (DM * 2)), (unsigned)f2bf(o)); \
      } \
    } \
    for (int vt = 0; vt < 2; ++vt) { \
      f32x4 a = Sacc[vt]; \
      for (int j = 0; j < 4; ++j) a[j] *= ds_[k][j]; \
      a = __builtin_amdgcn_mfma_f32_16x16x32_bf16(Ks[k], Vs[k][vt], a, 0, 0, 0); \
      Sacc[vt] = a; \
      for (int j = 0; j < 4; ++j) STs[(((k) + 1) & 1) * (32 * 136) + (vt * 16 + fr) * 136 + 16 * w + fq * 4 + j] = f2bf(a[j]); \
    } } while (0)
#pragma unroll
  for (int k = 0; k < 4; ++k) GLA_LOAD(k, min(k, nst - 1));
  int st0 = 0;
  for (; st0 + 3 < nst; st0 += 4) {
#pragma unroll
    for (int k = 0; k < 4; ++k) {
      const int st = st0 + k;
      GLA_STEP(k, st);
      GLA_LOAD(k, min(st + 4, nst - 1));
      LBAR();
    }
  }
#pragma unroll
  for (int k = 0; k < 4; ++k) {
    const int st = st0 + k;
    if (st < nst) { GLA_STEP(k, st); LBAR(); }
  }
#undef GLA_STEP
#undef LBAR
#undef GLA_LOAD
  float* so = p.out + (prompt ? O_HP : O_HS) + (((size_t)l * 8 + sb) * 4 + h) * 128 * 128;
#pragma unroll
  for (int vt = 0; vt < 2; ++vt)
#pragma unroll
    for (int j = 0; j < 4; ++j) so[(size_t)(16 * w + fq * 4 + j) * 128 + vq * 32 + vt * 16 + fr] = Sacc[vt][j];
}

__device__ void phase_pre(const KP& p, int l) {
  for (int u = p.bid; u < 1056; u += p.nblk) ssd_pre(p, l, u >> 1, u & 1);
  int lo, hi;
  if (p.nblk == 256) { if (p.bid < 32) { lo = p.bid * 13; hi = lo + 13; } else { lo = 416 + (p.bid - 32) * 17; hi = lo + 17; } }
  else { lo = (int)((long)4224 * p.bid / p.nblk); hi = (int)((long)4224 * (p.bid + 1) / p.nblk); }
  bfr qn[8], fn[8]; u32x4 vv;
  for (int v = lo; v < hi; ++v) {
    const bool have = (v > lo) && ((v & 3) != 0);
    const bool want = (v + 1 < hi) && (((v + 1) & 3) != 0);
    gla_pre(p, l, v >> 2, v & 3, qn, fn, vv, have, want);
  }
}

__device__ void phase_seq(const KP& p, int l) {
  for (int u = p.bid; u < 512; u += p.nblk) {
    int uu = u & 255, soff = (u >= 256) ? 8 : 0;
    if (uu < 128) ssd_seq(p, l, soff + (uu >> 4), (uu & 15) >> 1, uu & 1);
    else { int v = uu - 128; gla_seq(p, l, soff + (v >> 4), (v & 15) >> 2, v & 3); }
    __syncthreads();
  }
}


#define XB_TMO      128
#define XB_XCNT(j)  (256  + 64 * (j))
#define XB_XSUB(j)  (1280 + 64 * (j))
#define XB_XGEN(j)  (2304 + 64 * (j))
#define XB_TOP      3328
#define XB_TOPGEN   3392
#define XCD_BAR_WORDS 3456
#define XB_SPIN_CAP (1u << 18)
#define LAS __attribute__((address_space(3)))
__device__ __forceinline__ unsigned xb_ld(unsigned* p)              { return __hip_atomic_load(p, __ATOMIC_RELAXED, __HIP_MEMORY_SCOPE_AGENT); }
__device__ __forceinline__ unsigned xb_add(unsigned* p, unsigned v) { return __hip_atomic_fetch_add(p, v, __ATOMIC_RELAXED, __HIP_MEMORY_SCOPE_AGENT); }
__device__ __forceinline__ unsigned xb_xcc_id() { return (unsigned)__builtin_amdgcn_s_getreg((3 << 11) | 20) & 0xFu; }
#define XB_SPIN(cond, bar) do { unsigned _sp = 0; while (cond) { __builtin_amdgcn_s_sleep(1); \
    if ((++_sp & 255u) == 0u) { if (xb_ld(&(bar)[XB_TMO])) break; if (_sp > XB_SPIN_CAP) { atomicAdd(&(bar)[XB_TMO], 1u); break; } } } } while (0)
struct XcdBarrier { unsigned* bar; unsigned x; volatile LAS unsigned* st; };
__device__ __forceinline__ XcdBarrier xcd_barrier_post(unsigned* bar, volatile LAS unsigned* st) {
  XcdBarrier b; b.bar = bar; b.x = xb_xcc_id(); b.st = st;
  if (threadIdx.x == 0) (void)xb_add(&bar[XB_XCNT(b.x)], 1u);
  return b;
}
__device__ __forceinline__ void xcd_barrier_complete(unsigned* bar, unsigned x, unsigned& nloc, unsigned& nx) {
  const unsigned G = gridDim.x * gridDim.y * gridDim.z;
  unsigned sum, cnt, mine, sp = 0u;
  for (;;) {
    sum = 0u; cnt = 0u; mine = 0u;
#pragma unroll
    for (unsigned j = 0; j < 16; ++j) { const unsigned c = xb_ld(&bar[XB_XCNT(j)]); sum += c; cnt += (c > 0u) ? 1u : 0u; mine = (j == x) ? c : mine; }
    if (sum == G) break;
    __builtin_amdgcn_s_sleep(1);
    if ((++sp & 255u) == 0u) { if (xb_ld(&bar[XB_TMO])) break; if (sp > XB_SPIN_CAP) { atomicAdd(&bar[XB_TMO], 1u); break; } }
  }
  nloc = mine > 0u ? mine : 1u; nx = cnt > 0u ? cnt : 1u;
}
__device__ __forceinline__ void xcd_barrier(const XcdBarrier& b) {
  asm volatile("s_waitcnt vmcnt(0)" ::: "memory");
  __syncthreads();
  if (threadIdx.x == 0) {
    unsigned* bar = b.bar; asm volatile("" : "+s"(bar));
    __builtin_amdgcn_s_waitcnt(0);
    unsigned nloc = b.st[0], nx = b.st[1];
    if (nloc == 0u) { xcd_barrier_complete(bar, b.x, nloc, nx); b.st[0] = nloc; b.st[1] = nx; }
    const unsigned old = xb_add(&bar[XB_XSUB(b.x)], 1u);
    const unsigned gen = old / nloc;
    if (old + 1u == (gen + 1u) * nloc) {
      __builtin_amdgcn_fence(__ATOMIC_RELEASE, "agent");
      asm volatile("s_waitcnt vmcnt(0)" ::: "memory");
      const unsigned og = xb_add(&bar[XB_TOP], 1u);
      const unsigned tg = og / nx;
      if (og + 1u == (tg + 1u) * nx) xb_add(&bar[XB_TOPGEN], 1u);
      else XB_SPIN(xb_ld(&bar[XB_TOPGEN]) == tg, bar);
      __builtin_amdgcn_fence(__ATOMIC_ACQUIRE, "agent");
      xb_add(&bar[XB_XGEN(b.x)], 1u);
      asm volatile("s_waitcnt vmcnt(0)" ::: "memory");
    } else {
      XB_SPIN(xb_ld(&bar[XB_XGEN(b.x)]) == gen, bar);
      __builtin_amdgcn_fence(__ATOMIC_ACQUIRE, "agent");
      asm volatile("s_waitcnt vmcnt(0)" ::: "memory");
    }
  }
  __syncthreads();
}

__device__ void run_phase(const KP& p_, int ph) {
  KP p = p_;
  {
    unsigned long long w_ = (unsigned long long)p_.ws, o_ = (unsigned long long)p_.out;
    unsigned wl = __builtin_amdgcn_readfirstlane((unsigned)w_), wh = __builtin_amdgcn_readfirstlane((unsigned)(w_ >> 32));
    unsigned ol = __builtin_amdgcn_readfirstlane((unsigned)o_), oh = __builtin_amdgcn_readfirstlane((unsigned)(o_ >> 32));
    int b_ = __builtin_amdgcn_readfirstlane((int)blockIdx.x), n_ = __builtin_amdgcn_readfirstlane((int)gridDim.x);
    asm volatile("" : "+s"(wl), "+s"(wh), "+s"(ol), "+s"(oh), "+s"(b_), "+s"(n_));
    p.ws = (unsigned char*)(__attribute__((address_space(1))) unsigned char*)(((unsigned long long)wh << 32) | (unsigned long long)wl);
    p.out = (float*)(__attribute__((address_space(1))) float*)(((unsigned long long)oh << 32) | (unsigned long long)ol);
    p.bid = b_; p.nblk = n_;
  }
  const bfr* W = (const bfr*)(p.ws + OFF_W);
  const bfr* hb = (const bfr*)(p.ws + OFF_HB);
  const bfr* U = (const bfr*)(p.ws + OFF_U);
  const bfr* mix = (const bfr*)(p.ws + OFF_MIX);
  int plo = 0, phi = 0, pfirst = 16;
  if (ph == 0) { phi = 1408; pfirst = 0; }
  else {
    int l = (ph - 1) / 12, q = (ph - 1) % 12;
    const bfr* Wl = W + (size_t)l * W_LAYER;
    if (q == 2 || q == 8 || (q == 11 && l == 0)) { phase_stat(p); return; }
    if (q == 11) { phase_final(p); return; }
    if (q == 4) { phase_pre(p, l); return; }
    if (q == 5) { phase_seq(p, l); return; }
    if (q == 6) { phase_mixnorm(p, l); return; }
    if (q == 0) { gemm_phase<1, NGU, DM>(p, l, hb, Wl + W_GUA); if (l == 0) { plo = 1408; phi = 2112; pfirst = (132 * 22) % p.nblk; } }
    else if (q == 1) { gemm_phase<2, DM, DFF>(p, l, U, Wl + W_DA); if (l == 0) { plo = 2112; phi = 5440; } else { plo = 7552; phi = 10880; } }
    else if (q == 3) gemm_phase<3, NINP, DM>(p, l, hb, Wl + W_IN);
    else if (q == 7) { gemm_phase<2, DM, DM>(p, l, mix, Wl + W_OUT); if (l == 0) { plo = 5440; phi = 6140; } }
    else if (q == 9) gemm_phase<1, NGU, DM>(p, l, hb, Wl + W_GUB);
    else { gemm_phase<2, DM, DFF>(p, l, U, Wl + W_DB); if (l == 0) { plo = 6140; phi = 7552; } }
  }
  if (phi > plo) { __syncthreads(); phase_prep(p, plo, phi, pfirst); }
  if (ph == 0) phase_init(p);
}

__global__ void __launch_bounds__(512, 2) hymba_fwd(KP p) {
  extern __shared__ __attribute__((aligned(16))) unsigned char smem[];
  volatile LAS unsigned* st = (volatile LAS unsigned*)(smem + 131072);
  if (threadIdx.x == 0) { st[0] = 0u; st[1] = 0u; }
  __syncthreads();
  XcdBarrier xb = xcd_barrier_post((unsigned*)(p.ws + OFF_BAR), st);
  for (int ph = p.ph_lo; ph < p.ph_hi; ++ph) {
    run_phase(p, ph);
    if (ph + 1 < p.ph_hi) { if (ph < 0) cg::this_grid().sync(); else xcd_barrier(xb); }
  }
}

extern "C" void kernel_launch(void* const* d_in, const int* in_sizes, int n_in, void* d_out, int out_size,
                              void* d_ws, size_t ws_size, hipStream_t stream) {
  static int grid = 0;
  if (!grid) {
    int dev = 0, cus = 0, per_cu = 0;
    hipGetDevice(&dev);
    hipDeviceGetAttribute(&cus, hipDeviceAttributeMultiprocessorCount, dev);
    hipFuncSetAttribute((const void*)hymba_fwd, hipFuncAttributeMaxDynamicSharedMemorySize, LDS_BYTES);
    hipOccupancyMaxActiveBlocksPerMultiprocessor(&per_cu, (const void*)hymba_fwd, 512, LDS_BYTES);
    if (per_cu < 1) per_cu = 1;
    grid = cus * per_cu;
    if (grid > 256) grid = 256;
  }
  hipMemsetAsync((char*)d_ws + OFF_BAR, 0, XCD_BAR_WORDS * 4, stream);
  KP p{};
  for (int i = 0; i < 26; ++i) p.in[i] = (const float*)d_in[i];
  p.out = (float*)d_out; p.ws = (unsigned char*)d_ws;
#if SINGLE_LAUNCH
  p.ph_lo = 0; p.ph_hi = NPHASE;
  void* args[] = {&p};
  hipError_t e = hipLaunchCooperativeKernel((const void*)hymba_fwd, dim3(grid), dim3(512), args, LDS_BYTES, stream);
  if (e != hipSuccess) fprintf(stderr, "cooperative launch failed: %s (grid %d)\n", hipGetErrorString(e), grid);
#else
  for (int ph = 0; ph < NPHASE; ++ph) {
    p.ph_lo = ph; p.ph_hi = ph + 1;
    hipLaunchKernelGGL(hymba_fwd, dim3(grid), dim3(512), LDS_BYTES, stream, p);
  }
#endif
}
```

```cpp
#include <hip/hip_runtime.h>
#include <hip/hip_bf16.h>
#include <hip/hip_cooperative_groups.h>
#include <cstdio>
namespace cg = cooperative_groups;

#ifndef SINGLE_LAUNCH
#define SINGLE_LAUNCH 1
#endif

typedef unsigned short bfr;
using bf16x8 = __attribute__((ext_vector_type(8))) short;
using f32x4  = __attribute__((ext_vector_type(4))) float;
using u32x4  = __attribute__((ext_vector_type(4))) unsigned;

constexpr int T_ROWS = 33792;
constexpr int PROW = 4160, PLEN = 4112, SROW0 = 33280;
constexpr int DM = 1024, DFF = 2816, NGU = 5632, NIN = 3584, NINP = 3840;
constexpr float EPSF = 1e-6f;
constexpr size_t OFF_HB = 0;
constexpr size_t OFF_RS = 69206016;
constexpr size_t OFF_DT = 69341184;
constexpr size_t OFF_U = 70422528;
constexpr size_t OFF_MIX = 312643584;
constexpr size_t OFF_W = 381849600;
constexpr size_t W_GUA = 0, W_DA = 5767168, W_IN = 8650752, W_OUT = 12582912, W_GUB = 13631488, W_DB = 19398656, W_LAYER = 22282240;
constexpr size_t O_YP = 0, O_YS = 33554432, O_CP = 34078720, O_SP = 34127872, O_HP = 35176448, O_CS = 36225024, O_SS = 36274176, O_HS = 37322752;
constexpr size_t OFF_TAILS = 470978560;
constexpr size_t OFF_DEC = 474222592;
constexpr size_t OFF_BAR = 476385280;
constexpr int LDS_BYTES = 131072 + 16;
constexpr int NPHASE = 25;

struct KP {
  const float* in[26];
  float* out;
  unsigned char* ws;
  int ph_lo, ph_hi;
  int bid, nblk;
};

typedef __bf16 bf16v2_t __attribute__((ext_vector_type(2)));
typedef float f32v2_t __attribute__((ext_vector_type(2)));
__device__ __forceinline__ unsigned pack2(float a, float b) { f32v2_t v = {a, b}; bf16v2_t r = __builtin_convertvector(v, bf16v2_t); return __builtin_bit_cast(unsigned, r); }
__device__ __forceinline__ bfr f2bf(float f) { return (bfr)(pack2(f, f) & 0xffffu); }
__device__ __forceinline__ float bf2f(bfr b) { return __uint_as_float(((unsigned)b) << 16); }
__device__ __forceinline__ float siluf(float x) { return x * __builtin_amdgcn_rcpf(1.f + __builtin_amdgcn_exp2f(x * -1.44269504f)); }

struct PrepMeta { int l, K, n0, k0; size_t woff; };
__device__ __forceinline__ void prep_load(const KP& p, int job, int tid, float (&v)[8], PrepMeta& m) {
  int l = job / 5440, j = job % 5440;
  int mat, nt, kt, K; size_t woff;
  const float *s0, *s1, *sc; int ldn; float cs;
  if (j < 1408) { mat = 0; nt = j / 16; kt = j % 16; K = DM; woff = W_GUA; s0 = p.in[7] + (size_t)l * DM * DFF; s1 = p.in[8] + (size_t)l * DM * DFF; sc = p.in[6] + l * DM; ldn = DFF; cs = 1.f; }
  else if (j < 2112) { j -= 1408; mat = 1; nt = j / 44; kt = j % 44; K = DFF; woff = W_DA; s0 = s1 = p.in[9] + (size_t)l * DFF * DM; sc = nullptr; ldn = DM; cs = 0.5f; }
  else if (j < 3072) { j -= 2112; mat = 2; nt = j / 16; kt = j % 16; K = DM; woff = W_IN; s0 = s1 = p.in[11] + (size_t)l * DM * 3592; sc = p.in[10] + l * DM; ldn = 3592; cs = 1.f; }
  else if (j < 3328) { j -= 3072; mat = 3; nt = j / 16; kt = j % 16; K = DM; woff = W_OUT; s0 = s1 = p.in[20] + (size_t)l * DM * DM; sc = nullptr; ldn = DM; cs = 1.f; }
  else if (j < 4736) { j -= 3328; mat = 0; nt = j / 16; kt = j % 16; K = DM; woff = W_GUB; s0 = p.in[22] + (size_t)l * DM * DFF; s1 = p.in[23] + (size_t)l * DM * DFF; sc = p.in[21] + l * DM; ldn = DFF; cs = 1.f; }
  else { j -= 4736; mat = 1; nt = j / 44; kt = j % 44; K = DFF; woff = W_DB; s0 = s1 = p.in[24] + (size_t)l * DFF * DM; sc = nullptr; ldn = DM; cs = 0.5f; }
  const int n0 = nt * 64, k0 = kt * 64;
  m.l = l; m.K = K; m.n0 = n0; m.k0 = k0; m.woff = woff;
#pragma unroll
  for (int it = 0; it < 8; ++it) {
    int e = tid + 512 * it, kk = e >> 6, nn = e & 63;
    int k = k0 + kk, n = n0 + nn, c; bool ok = true; const float* sp = s0;
    const int nl = n & 255, bj = nl >> 7, wc_ = (nl >> 5) & 3, ns = (nl >> 4) & 1, r = nl & 15;
    if (mat == 0) { c = (n >> 8) * 128 + wc_ * 32 + (r >> 2) * 8 + bj * 4 + (r & 3); if (ns) sp = s1; }
    else {
      c = (n & ~255) + bj * 128 + wc_ * 32 + (r >> 2) * 8 + ns * 4 + (r & 3);
      if (mat == 2) { if (c < 1536) c = c; else if (c < 3584) c = c + 8; else if (c < 3592) c = 1536 + (c - 3584); else { ok = false; c = 0; } }
    }
    float x = sp[(size_t)k * ldn + c] * cs;
    if (sc) x *= sc[k];
    v[it] = ok ? x : 0.f;
  }
}
__device__ __forceinline__ void prep_tile_out(bfr* W, const float* tile, int tid, const float (&v)[8], const PrepMeta& m) {
#pragma unroll
  for (int it = 0; it < 8; ++it) { int e = tid + 512 * it; ((float*)tile)[(e >> 6) * 65 + (e & 63)] = v[it]; }
}
__device__ void phase_prep(const KP& p, int job_lo, int job_hi, int first_blk) {
  extern __shared__ __attribute__((aligned(16))) unsigned char smem[];
  int tid = threadIdx.x; asm volatile("" : "+v"(tid));
  bfr* W = (bfr*)(p.ws + OFF_W);
  const int total = (p.bid < first_blk) ? 0 : job_hi, stride = p.nblk - first_blk;
  float va[8], vb[8]; PrepMeta ma, mb;
  const int j0 = job_lo + (p.bid - first_blk);
  if (j0 < total) prep_load(p, j0, tid, va, ma);
  if (j0 + stride < total) prep_load(p, j0 + stride, tid, vb, mb);
  int buf = 0;
  for (int job = j0; job < total; job += 2 * stride) {
#pragma unroll
    for (int half = 0; half < 2; ++half) {
      const int jb = job + half * stride;
      if (jb < total) {
        float* tile = (float*)smem + buf * (64 * 65);
        PrepMeta mc = half ? mb : ma;
        if (half == 0) prep_tile_out(W, tile, tid, va, ma); else prep_tile_out(W, tile, tid, vb, mb);
        __syncthreads();
        if (jb + 2 * stride < total) { if (half == 0) prep_load(p, jb + 2 * stride, tid, va, ma); else prep_load(p, jb + 2 * stride, tid, vb, mb); }
        {
          int nn = tid >> 3, seg = tid & 7;
          u32x4 v;
          v[0] = pack2(tile[(seg * 8 + 0) * 65 + nn], tile[(seg * 8 + 1) * 65 + nn]);
          v[1] = pack2(tile[(seg * 8 + 2) * 65 + nn], tile[(seg * 8 + 3) * 65 + nn]);
          v[2] = pack2(tile[(seg * 8 + 4) * 65 + nn], tile[(seg * 8 + 5) * 65 + nn]);
          v[3] = pack2(tile[(seg * 8 + 6) * 65 + nn], tile[(seg * 8 + 7) * 65 + nn]);
          *(u32x4*)(W + (size_t)mc.l * W_LAYER + mc.woff + (size_t)(mc.n0 + nn) * mc.K + mc.k0 + seg * 8) = v;
        }
        buf ^= 1;
      }
    }
  }
  __syncthreads();
}

__device__ __forceinline__ float wave_sum(float v) {
#pragma unroll
  for (int o = 32; o >= 1; o >>= 1) v += __shfl_xor(v, o);
  return v;
}

__device__ void phase_init(const KP& p) {
  int tid_ = threadIdx.x; asm volatile("" : "+v"(tid_));
  const int lane = tid_ & 63, w = tid_ >> 6;
  bfr* hb = (bfr*)(p.ws + OFF_HB);
  float* rs = (float*)(p.ws + OFF_RS);
  for (int row = p.bid * 8 + w; row < T_ROWS; row += p.nblk * 8) {
    const float* src = nullptr;
    if (row < SROW0) {
      int s = row / PROW, pos = row % PROW;
      if (pos < 16) src = p.in[5] + (size_t)pos * DM;
      else if (pos < PLEN) src = p.in[0] + ((size_t)s * 4096 + (pos - 16)) * DM;
    } else src = p.in[1] + (size_t)(row - SROW0) * DM;
    float ss = 0.f;
#pragma unroll
    for (int i = 0; i < 4; ++i) {
      int c = 4 * (lane + 64 * i);
      float4 v = src ? *(const float4*)(src + c) : make_float4(0.f, 0.f, 0.f, 0.f);
      bfr b0 = f2bf(v.x), b1 = f2bf(v.y), b2 = f2bf(v.z), b3 = f2bf(v.w);
      float r0 = bf2f(b0), r1 = bf2f(b1), r2 = bf2f(b2), r3 = bf2f(b3);
      ss += r0 * r0 + r1 * r1 + r2 * r2 + r3 * r3;
      uint2 o; o.x = (unsigned)b0 | ((unsigned)b1 << 16); o.y = (unsigned)b2 | ((unsigned)b3 << 16);
      *(uint2*)(hb + (size_t)row * DM + c) = o;
    }
    ss = wave_sum(ss);
    if (lane == 0) rs[row] = rsqrtf(ss * (1.f / DM) + EPSF);
  }
}

__device__ void phase_stat(const KP& p) {
  int tid_ = threadIdx.x; asm volatile("" : "+v"(tid_));
  const int lane = tid_ & 63, w = tid_ >> 6;
  const bfr* hb = (const bfr*)(p.ws + OFF_HB);
  float* rs = (float*)(p.ws + OFF_RS);
  for (int row = p.bid * 8 + w; row < T_ROWS; row += p.nblk * 8) {
    float ss = 0.f;
#pragma unroll
    for (int i = 0; i < 2; ++i) {
      u32x4 v = *(const u32x4*)(hb + (size_t)row * DM + lane * 8 + 512 * i);
#pragma unroll
      for (int e = 0; e < 4; ++e) {
        float a = __uint_as_float(v[e] << 16), b = __uint_as_float(v[e] & 0xffff0000u);
        ss += a * a + b * b;
      }
    }
    ss = wave_sum(ss);
    if (lane == 0) rs[row] = rsqrtf(ss * (1.f / DM) + EPSF);
  }
}

__device__ void phase_final(const KP& p) {
  int tid_ = threadIdx.x; asm volatile("" : "+v"(tid_));
  const int lane = tid_ & 63, w = tid_ >> 6;
  const bfr* hb = (const bfr*)(p.ws + OFF_HB);
  const float* lw = p.in[25];
  for (int row = p.bid * 8 + w; row < T_ROWS; row += p.nblk * 8) {
    float* dst;
    if (row < SROW0) {
      int s = row / PROW, pos = row % PROW;
      if (pos < 16 || pos >= PLEN) continue;
      dst = p.out + O_YP + ((size_t)s * 4096 + (pos - 16)) * DM;
    } else dst = p.out + O_YS + (size_t)(row - SROW0) * DM;
    float x[16];
    float ss = 0.f;
#pragma unroll
    for (int i = 0; i < 2; ++i) {
      u32x4 v = *(const u32x4*)(hb + (size_t)row * DM + lane * 8 + 512 * i);
#pragma unroll
      for (int e = 0; e < 4; ++e) {
        float a = __uint_as_float(v[e] << 16), b = __uint_as_float(v[e] & 0xffff0000u);
        x[i * 8 + e * 2] = a; x[i * 8 + e * 2 + 1] = b;
        ss += a * a + b * b;
      }
    }
    ss = wave_sum(ss);
    float r = rsqrtf(ss * (1.f / DM) + EPSF);
#pragma unroll
    for (int i = 0; i < 2; ++i) {
      int c = lane * 8 + 512 * i;
      float4 w0 = *(const float4*)(lw + c), w1 = *(const float4*)(lw + c + 4);
      float4 o0 = make_float4(x[i * 8 + 0] * r * w0.x, x[i * 8 + 1] * r * w0.y, x[i * 8 + 2] * r * w0.z, x[i * 8 + 3] * r * w0.w);
      float4 o1 = make_float4(x[i * 8 + 4] * r * w1.x, x[i * 8 + 5] * r * w1.y, x[i * 8 + 6] * r * w1.z, x[i * 8 + 7] * r * w1.w);
      *(float4*)(dst + c) = o0; *(float4*)(dst + c + 4) = o1;
    }
  }
}

__device__ void phase_mixnorm(const KP& p, int l) {
  int tid_ = threadIdx.x; asm volatile("" : "+v"(tid_));
  const int lane = tid_ & 63, w = tid_ >> 6;
  bfr* mix = (bfr*)(p.ws + OFF_MIX);
  const bfr* proj = (const bfr*)(p.ws + OFF_U);
  for (int row = p.bid * 8 + w; row < T_ROWS; row += p.nblk * 8) {
    bfr* mp = mix + (size_t)row * DM + lane * 16;
    u32x4 v0 = *(const u32x4*)mp, v1 = *(const u32x4*)(mp + 8);
    float x[16];
#pragma unroll
    for (int e = 0; e < 4; ++e) {
      x[e * 2] = __uint_as_float(v0[e] << 16); x[e * 2 + 1] = __uint_as_float(v0[e] & 0xffff0000u);
      x[8 + e * 2] = __uint_as_float(v1[e] << 16); x[8 + e * 2 + 1] = __uint_as_float(v1[e] & 0xffff0000u);
    }
    float ss = 0.f;
#pragma unroll
    for (int e = 0; e < 16; ++e) ss += x[e] * x[e];
    ss += __shfl_xor(ss, 1); ss += __shfl_xor(ss, 2); ss += __shfl_xor(ss, 4);
    float s8 = __shfl_xor(ss, 8);
    float r;
    if (lane < 32) r = rsqrtf((ss + s8) * (1.f / 256.f) + EPSF);
    else r = rsqrtf(ss * (1.f / 128.f) + EPSF);
    float o[16];
    if (lane < 32) {
      const float* nw = p.in[17] + l * 512 + lane * 16;
#pragma unroll
      for (int e = 0; e < 16; ++e) o[e] = x[e] * r * nw[e];
    } else {
      int cg0 = (lane - 32) * 16;
      const float* nw = p.in[19] + l * 512 + cg0;
      const bfr* gp = proj + (size_t)row * NIN + 3072 + cg0;
      u32x4 g0 = *(const u32x4*)gp, g1 = *(const u32x4*)(gp + 8);
      float g[16];
#pragma unroll
      for (int e = 0; e < 4; ++e) {
        g[e * 2] = __uint_as_float(g0[e] << 16); g[e * 2 + 1] = __uint_as_float(g0[e] & 0xffff0000u);
        g[8 + e * 2] = __uint_as_float(g1[e] << 16); g[8 + e * 2 + 1] = __uint_as_float(g1[e] & 0xffff0000u);
      }
#pragma unroll
      for (int e = 0; e < 16; ++e) o[e] = x[e] * r * nw[e] * siluf(g[e]);
    }
    u32x4 w0, w1;
#pragma unroll
    for (int e = 0; e < 4; ++e) { w0[e] = pack2(o[e * 2], o[e * 2 + 1]); w1[e] = pack2(o[8 + e * 2], o[8 + e * 2 + 1]); }
    *(u32x4*)mp = w0; *(u32x4*)(mp + 8) = w1;
  }
}

constexpr int BM = 256, BK = 64, HALF = 128, NXCD = 8, WGM = 8, HT = HALF * BK;

__device__ __forceinline__ int lds_byte(int r, int c) {
  int st = (r >> 4) * 2 + (c >> 5), rr = r & 15, cc = c & 31, ob = rr * 64 + cc * 2;
  return st * 1024 + (ob ^ (((ob >> 9) & 1) << 5));
}
__device__ __forceinline__ void stage_rc(int b, int& R, int& C) {
  int st = b / 1024, sb = b % 1024, swz = sb ^ (((sb >> 9) & 1) << 5);
  R = (st >> 1) * 16 + swz / 64; C = (st & 1) * 32 + (swz % 64) / 2;
}

template <int EPI, int N, int K>
__device__ __forceinline__ void gemm_phase(const KP& p, int l, const bfr* A, const bfr* Bt) {
  extern __shared__ __attribute__((aligned(16))) unsigned char smem[];
  bfr* shm = (bfr*)smem;
#define SA(b, h) (shm + ((b) * 2 + (h)) * HT)
#define SB(b, h) (shm + (4 + (b) * 2 + (h)) * HT)
#define STAGE_B(P, BASE, br, kt) do { const char* _gb = (const char*)((BASE) + (long)(br) * K + (long)(kt) * BK); \
    unsigned _o0 = so0, _o1 = so1; asm volatile("" : "+v"(_o0), "+v"(_o1)); \
    __builtin_amdgcn_global_load_lds((const unsigned*)(_gb + _o0), (unsigned*)((char*)(P) + tid * 16), 16, 0, 0); \
    __builtin_amdgcn_global_load_lds((const unsigned*)(_gb + _o1), (unsigned*)((char*)(P) + tid * 16 + 8192), 16, 0, 0); } while (0)
#define STAGE_A(P, BASE, br, kt) STAGE_B(P, BASE, br, kt)
#define LDA(dst, b, h) for (int m = 0; m < 4; ++m) for (int k = 0; k < 2; ++k) \
    dst[m][k] = *reinterpret_cast<const bf16x8*>((char*)SA(b, h) + lds_byte(wr * 64 + m * 16 + fr, k * 32 + fq * 8))
#define LDB(dst, b, h) for (int n = 0; n < 2; ++n) for (int k = 0; k < 2; ++k) \
    dst[n][k] = *reinterpret_cast<const bf16x8*>((char*)SB(b, h) + lds_byte(wc * 32 + n * 16 + fr, k * 32 + fq * 8))
#define MMA(ai, bj, At, Bq) do { __builtin_amdgcn_s_setprio(1); \
    for (int m = 0; m < 4; ++m) for (int n = 0; n < 2; ++n) for (int k = 0; k < 2; ++k) \
      acc[ai][bj][m][n] = __builtin_amdgcn_mfma_f32_16x16x32_bf16(Bq[n][k], At[m][k], acc[ai][bj][m][n], 0, 0, 0); \
    __builtin_amdgcn_s_setprio(0); } while (0)
#define WAIT_V(n) asm volatile("s_waitcnt vmcnt(" #n ")" ::: "memory")
#define WAIT_L(n) asm volatile("s_waitcnt lgkmcnt(" #n ")" ::: "memory")
#define BAR __builtin_amdgcn_s_barrier()
#define SCHED __builtin_amdgcn_sched_barrier(0)

  constexpr int TM = 256, HM = 128;
  const int nM = T_ROWS / TM, nN = N / BM, nwg = nM * nN;
  int tid = threadIdx.x; asm volatile("" : "+v"(tid));
  const int wid = tid >> 6, lane = tid & 63, wr = wid >> 2, wc = wid & 3, fr = lane & 15, fq = lane >> 4;
  const int nt = K / BK;
  unsigned so0, so1;
  { int _r, _c; stage_rc(tid * 16, _r, _c); so0 = (unsigned)(_r * K + _c) * 2u; stage_rc(tid * 16 + 8192, _r, _c); so1 = (unsigned)(_r * K + _c) * 2u; }
#define TILE_COORDS(LT, BROW, BCOL, PN) do { int wgid = (LT); \
    { int q = nwg / NXCD, r = nwg % NXCD, xcd = wgid % NXCD, off = wgid / NXCD; \
      wgid = (xcd < r ? xcd * (q + 1) : r * (q + 1) + (xcd - r) * q) + off; } \
    int nig = WGM * nN, gid = wgid / nig, fm = gid * WGM, gsz = min(nM - fm, WGM); \
    int pm_ = fm + ((wgid % nig) % gsz); PN = (wgid % nig) / gsz; BROW = pm_ * TM; BCOL = PN * BM; } while (0)
  int brow = 0, bcol = 0, pn = 0;
  if (p.bid < nwg) {
    TILE_COORDS(p.bid, brow, bcol, pn);
    STAGE_B(SB(0, 0), Bt, bcol, 0); STAGE_A(SA(0, 0), A, brow, 0);
    STAGE_B(SB(0, 1), Bt, bcol + HALF, 0); STAGE_A(SA(0, 1), A, brow + HM, 0);
  }
  for (int Lt = p.bid; Lt < nwg; Lt += p.nblk) {
    f32x4 acc[2][2][4][2];
#pragma unroll
    for (int a = 0; a < 2; ++a)
#pragma unroll
      for (int b = 0; b < 2; ++b)
#pragma unroll
        for (int m = 0; m < 4; ++m)
#pragma unroll
          for (int n = 0; n < 2; ++n) acc[a][b][m][n] = f32x4{0.f, 0.f, 0.f, 0.f};
    bf16x8 At[4][2], B0[2][2], B1[2][2];
    if (wr == 1) BAR;
    WAIT_V(4); BAR;
    STAGE_B(SB(1, 0), Bt, bcol, 1); STAGE_A(SA(1, 0), A, brow, 1); STAGE_B(SB(1, 1), Bt, bcol + HALF, 1);
    WAIT_V(6); BAR;
    for (int t = 0; t < nt - 2; t += 2) {
      LDB(B0, 0, 0); SCHED; LDA(At, 0, 0); STAGE_A(SA(1, 1), A, brow + HM, t + 1);
      WAIT_L(8); BAR; WAIT_L(0); MMA(0, 0, At, B0); BAR; SCHED;
      LDB(B1, 0, 1); STAGE_B(SB(0, 0), Bt, bcol, t + 2);
      BAR; WAIT_L(0); MMA(0, 1, At, B1); BAR;
      LDA(At, 0, 1); STAGE_A(SA(0, 0), A, brow, t + 2);
      BAR; WAIT_L(0); MMA(1, 0, At, B0); BAR; SCHED;
      STAGE_B(SB(0, 1), Bt, bcol + HALF, t + 2);
      WAIT_V(6); BAR; MMA(1, 1, At, B1); BAR;
      LDB(B0, 1, 0); SCHED; LDA(At, 1, 0); STAGE_A(SA(0, 1), A, brow + HM, t + 2);
      WAIT_L(8); BAR; WAIT_L(0); MMA(0, 0, At, B0); BAR; SCHED;
      LDB(B1, 1, 1); STAGE_B(SB(1, 0), Bt, bcol, t + 3);
      BAR; WAIT_L(0); MMA(0, 1, At, B1); BAR;
      LDA(At, 1, 1); STAGE_A(SA(1, 0), A, brow, t + 3);
      BAR; WAIT_L(0); MMA(1, 0, At, B0); BAR; SCHED;
      STAGE_B(SB(1, 1), Bt, bcol + HALF, t + 3);
      WAIT_V(6); BAR; MMA(1, 1, At, B1); BAR;
    }
    { LDB(B0, 0, 0); LDA(At, 0, 0); STAGE_A(SA(1, 1), A, brow + HM, nt - 1);
      BAR; WAIT_L(0); MMA(0, 0, At, B0); BAR;
      LDB(B1, 0, 1); BAR; WAIT_L(0); MMA(0, 1, At, B1); BAR;
      LDA(At, 0, 1); WAIT_V(4); BAR; WAIT_L(0); MMA(1, 0, At, B0); MMA(1, 1, At, B1); BAR; }
    { LDB(B0, 1, 0); LDA(At, 1, 0); WAIT_V(2); BAR; WAIT_L(0); MMA(0, 0, At, B0); BAR;
      LDB(B1, 1, 1); WAIT_V(0); BAR; WAIT_L(0); MMA(0, 1, At, B1); BAR;
      LDA(At, 1, 1); BAR; WAIT_L(0); MMA(1, 0, At, B0); MMA(1, 1, At, B1); BAR; }
    if (wr == 0) BAR;
    const int erow = brow, ecol = bcol, epn = pn;
    if (Lt + p.nblk < nwg) {
      TILE_COORDS(Lt + p.nblk, brow, bcol, pn);
      STAGE_B(SB(0, 0), Bt, bcol, 0); STAGE_A(SA(0, 0), A, brow, 0);
      STAGE_B(SB(0, 1), Bt, bcol + HALF, 0); STAGE_A(SA(0, 1), A, brow + HM, 0);
    }

    const float* rs = (const float*)(p.ws + OFF_RS);
    if (EPI == 1) {
      bfr* act = (bfr*)(p.ws + OFF_U);
#pragma unroll
      for (int ai = 0; ai < 2; ++ai)
#pragma unroll
        for (int m = 0; m < 4; ++m) {
          int row = erow + ai * HM + wr * 64 + m * 16 + fr;
          const float r = rs[row];
          const float nrl = -1.44269504f * r, r2 = r * r;
          u32x4 pk;
#pragma unroll
          for (int bj = 0; bj < 2; ++bj)
#pragma unroll
            for (int jj = 0; jj < 2; ++jj) {
              f32v2_t g2 = {acc[ai][bj][m][0][2 * jj], acc[ai][bj][m][0][2 * jj + 1]};
              f32v2_t u2 = {acc[ai][bj][m][1][2 * jj], acc[ai][bj][m][1][2 * jj + 1]};
              f32v2_t t2 = g2 * nrl;
              f32v2_t e2 = {__builtin_amdgcn_exp2f(t2.x), __builtin_amdgcn_exp2f(t2.y)};
              f32v2_t d2 = e2 + 1.0f;
              f32v2_t rc = {__builtin_amdgcn_rcpf(d2.x), __builtin_amdgcn_rcpf(d2.y)};
              f32v2_t o2 = (g2 * u2) * r2 * rc;
              pk[bj * 2 + jj] = pack2(o2.x, o2.y);
            }
          *(u32x4*)(act + (size_t)row * DFF + (ecol >> 1) + wc * 32 + fq * 8) = pk;
        }
    } else if (EPI == 2) {
      bfr* hb = (bfr*)(p.ws + OFF_HB);
#pragma unroll
      for (int ai = 0; ai < 2; ++ai)
#pragma unroll
        for (int m = 0; m < 4; ++m) {
          int row = erow + ai * HM + wr * 64 + m * 16 + fr;
#pragma unroll
          for (int bj = 0; bj < 2; ++bj) {
            u32x4* hp = (u32x4*)(hb + (size_t)row * DM + ecol + bj * HALF + wc * 32 + fq * 8);
            u32x4 h = *hp, o;
#pragma unroll
            for (int q2 = 0; q2 < 4; ++q2) {
              f32v2_t hv2 = {__uint_as_float(h[q2] << 16), __uint_as_float(h[q2] & 0xffff0000u)};
              f32v2_t av2 = {acc[ai][bj][m][q2 >> 1][(q2 & 1) * 2], acc[ai][bj][m][q2 >> 1][(q2 & 1) * 2 + 1]};
              f32v2_t s2 = hv2 + av2;
              o[q2] = pack2(s2.x, s2.y);
            }
            *hp = o;
          }
        }
    } else {
      bfr* proj = (bfr*)(p.ws + OFF_U);
      float* dtb = (float*)(p.ws + OFF_DT);
#pragma unroll
      for (int ai = 0; ai < 2; ++ai)
#pragma unroll
        for (int m = 0; m < 4; ++m) {
          int row = erow + ai * HM + wr * 64 + m * 16 + fr;
          float r = rs[row];
          if (epn < 14) {
            float* cdst = nullptr;
            bfr* tdst = nullptr;
            if (ecol >= 512 && ecol < 1536) {
              { int cid, tl;
                if (row < SROW0) { int s = row / PROW, pos = row % PROW; cid = s * 65 + (pos >> 6); tl = (pos & 63) - 61; }
                else { int rr = row - SROW0; cid = 520 + (rr >> 6); tl = (rr & 63) - 61; }
                if (tl >= 0) tdst = (bfr*)(p.ws + OFF_TAILS) + ((size_t)cid * 3 + tl) * 1024; }
              if (row < SROW0) { int s = row / PROW, tl = row % PROW - (PLEN - 3); if (tl >= 0 && tl < 3) cdst = p.out + O_CP + ((size_t)(l * 8 + s) * 3 + tl) * 1024; }
              else { int s = (row - SROW0) >> 6, tl = ((row - SROW0) & 63) - 61; if (tl >= 0) cdst = p.out + O_CS + ((size_t)(l * 8 + s) * 3 + tl) * 1024; }
            }
#pragma unroll
            for (int bj = 0; bj < 2; ++bj) {
              int col = ecol + bj * HALF + wc * 32 + fq * 8;
              float v[8];
#pragma unroll
              for (int n = 0; n < 2; ++n)
#pragma unroll
                for (int jj = 0; jj < 2; ++jj) {
                  f32v2_t t2 = f32v2_t{acc[ai][bj][m][n][2 * jj], acc[ai][bj][m][n][2 * jj + 1]} * r;
                  v[n * 4 + 2 * jj] = t2.x; v[n * 4 + 2 * jj + 1] = t2.y;
                }
              u32x4 pk; pk[0] = pack2(v[0], v[1]); pk[1] = pack2(v[2], v[3]); pk[2] = pack2(v[4], v[5]); pk[3] = pack2(v[6], v[7]);
              *(u32x4*)(proj + (size_t)row * NIN + col) = pk;
              if (cdst) { *(float4*)(cdst + col - 512) = make_float4(v[0], v[1], v[2], v[3]); *(float4*)(cdst + col - 512 + 4) = make_float4(v[4], v[5], v[6], v[7]); }
              if (tdst) *(u32x4*)(tdst + col - 512) = pk;
            }
          } else {
            if (wc == 0 && fq == 0) {
              *(float4*)(dtb + (size_t)row * 8) = make_float4(acc[ai][0][m][0][0] * r, acc[ai][0][m][0][1] * r, acc[ai][0][m][0][2] * r, acc[ai][0][m][0][3] * r);
              *(float4*)(dtb + (size_t)row * 8 + 4) = make_float4(acc[ai][0][m][1][0] * r, acc[ai][0][m][1][1] * r, acc[ai][0][m][1][2] * r, acc[ai][0][m][1][3] * r);
            }
          }
        }
    }
  }
#undef SA
#undef TILE_COORDS
#undef SB
#undef STAGE_A
#undef STAGE_B
#undef LDA
#undef LDB
#undef MMA
}

__device__ __forceinline__ f32x4 mma_lds(const bfr* A, int lda, const bfr* B, int ldb, int ksteps, f32x4 acc, int fr, int fq) {
  for (int ks = 0; ks < ksteps; ++ks) {
    bf16x8 a = *(const bf16x8*)(A + fr * lda + ks * 32 + fq * 8);
    bf16x8 b = *(const bf16x8*)(B + fr * ldb + ks * 32 + fq * 8);
    acc = __builtin_amdgcn_mfma_f32_16x16x32_bf16(a, b, acc, 0, 0, 0);
  }
  return acc;
}

__device__ __forceinline__ f32x4 mma_gl(const bf16x8* af, const bfr* B, int ldb, int ksteps, f32x4 acc, int fr, int fq) {
  bf16x8 b0 = *(const bf16x8*)(B + fr * ldb + 0 * 32 + fq * 8);
  bf16x8 b1 = *(const bf16x8*)(B + fr * ldb + 1 * 32 + fq * 8);
  bf16x8 b2 = *(const bf16x8*)(B + fr * ldb + 2 * 32 + fq * 8);
  bf16x8 b3 = *(const bf16x8*)(B + fr * ldb + 3 * 32 + fq * 8);
  f32x4 c0 = acc, c1 = f32x4{0.f, 0.f, 0.f, 0.f};
  c0 = __builtin_amdgcn_mfma_f32_16x16x32_bf16(af[0], b0, c0, 0, 0, 0);
  c1 = __builtin_amdgcn_mfma_f32_16x16x32_bf16(af[1], b1, c1, 0, 0, 0);
  c0 = __builtin_amdgcn_mfma_f32_16x16x32_bf16(af[2], b2, c0, 0, 0, 0);
  c1 = __builtin_amdgcn_mfma_f32_16x16x32_bf16(af[3], b3, c1, 0, 0, 0);
  (void)ksteps;
  return c0 + c1;
}

__device__ void ssd_pre(const KP& p, int l, int cid, int g) {
  extern __shared__ __attribute__((aligned(16))) unsigned char smem[];
  int tid_ = threadIdx.x; asm volatile("" : "+v"(tid_));
  const int tid = tid_, w = tid >> 6, lane = tid & 63, fr = lane & 15, fq = lane >> 4;
  bfr* Cs = (bfr*)smem;
  bfr* Bs = Cs + 64 * 136;
  bfr* BTs = Bs + 64 * 136;
  bfr* xTs = BTs + 128 * 72;
  bfr* Gs = xTs + 256 * 72;
  float* dtv = (float*)(Gs + 64 * 72);
  float* cumv = dtv + 256;
  float* ev = cumv + 256;

  bool prompt, first; int r0, pos0, len, sb = 0;
  if (cid < 520) { int s = cid / 65, c = cid % 65; prompt = true; first = (c == 0); r0 = s * PROW + c * 64; pos0 = c * 64; len = PLEN; }
  else { sb = cid - 520; prompt = false; first = true; r0 = SROW0 + sb * 64; pos0 = 0; len = 64; }
  bfr* proj = (bfr*)(p.ws + OFF_U);
  float* dtbuf = (float*)(p.ws + OFF_DT);
  bfr* mix = (bfr*)(p.ws + OFF_MIX);
  const bfr* tails = (const bfr*)(p.ws + OFF_TAILS);
  const float* convw = p.in[12] + (size_t)l * 4 * 1024;
  const float* convb = p.in[13] + (size_t)l * 1024;

  if (tid < 256) {
    int hh = tid >> 6, i = tid & 63, h = g * 4 + hh;
    float x = dtbuf[(size_t)(r0 + i) * 8 + h] + p.in[14][l * 8 + h];
    float dt = (x > 20.f) ? x : __logf(1.f + __expf(x));
    if (pos0 + i >= len) dt = 0.f;
    float cum = dt * (-__expf(p.in[15][l * 8 + h]));
#pragma unroll
    for (int o = 1; o < 64; o <<= 1) { float t = __shfl_up(cum, o); if (i >= o) cum += t; }
    float cl = __shfl(cum, 63);
    dtv[tid] = dt; cumv[tid] = cum; ev[tid] = dt * __expf(cl - cum);
    dtbuf[(size_t)(r0 + i) * 8 + h] = cum;
  }
  {
    const int item = tid;
    const int pair = item & 255, half_ = item >> 8, cc0 = pair * 2;
    const int rs_ = half_ * 32, re_ = rs_ + 32;
    const int ch = (cc0 < 256) ? (g * 256 + cc0) : ((cc0 < 384) ? (512 + g * 128 + cc0 - 256) : (768 + g * 128 + cc0 - 384));
    float w0[5], w1[5];
#pragma unroll
    for (int k = 0; k < 4; ++k) { w0[k] = convw[k * 1024 + ch]; w1[k] = convw[k * 1024 + ch + 1]; }
    w0[4] = convb[ch]; w1[4] = convb[ch + 1];
    float a0[3], a1[3];
#pragma unroll
    for (int k = 0; k < 3; ++k) {
      int rr = rs_ - 3 + k;
      float x0 = 0.f, x1 = 0.f;
      if (rr >= 0) { unsigned u = *(const unsigned*)(proj + (size_t)(r0 + rr) * NIN + 512 + ch); x0 = __uint_as_float(u << 16); x1 = __uint_as_float(u & 0xffff0000u); }
      else if (!first) { unsigned u = *(const unsigned*)(tails + ((size_t)(cid - 1) * 3 + (rr + 3)) * 1024 + ch); x0 = __uint_as_float(u << 16); x1 = __uint_as_float(u & 0xffff0000u); }
      else if (!prompt) { const float* sp = p.in[2] + (((size_t)l * 8 + sb) * 3 + (rr + 3)) * 1024 + ch; x0 = bf2f(f2bf(sp[0])); x1 = bf2f(f2bf(sp[1])); }
      a0[k] = x0; a1[k] = x1;
    }
    f32v2_t wv[5], av[3];
#pragma unroll
    for (int k = 0; k < 5; ++k) wv[k] = f32v2_t{w0[k], w1[k]};
#pragma unroll
    for (int k = 0; k < 3; ++k) av[k] = f32v2_t{a0[k], a1[k]};
    const bfr* gp = proj + (size_t)r0 * NIN + 512 + ch;
    int nin_ = NIN; asm volatile("" : "+s"(nin_));
    unsigned ur[32];
#pragma unroll
    for (int k = 0; k < 32; ++k) { int i = rs_ + k; ur[k] = *(const unsigned*)(gp + (size_t)i * nin_); }
#pragma unroll
    for (int k = 0; k < 32; ++k) {
      const int i = rs_ + k;
      if (i < re_) {
        unsigned u = ur[k];
        float x0 = __uint_as_float(u << 16), x1 = __uint_as_float(u & 0xffff0000u);
        f32v2_t xv = {x0, x1};
        f32v2_t vv = wv[4] + av[0] * wv[0] + av[1] * wv[1] + av[2] * wv[2] + xv * wv[3];
        av[0] = av[1]; av[1] = av[2]; av[2] = xv;
        f32v2_t tv = vv * -1.44269504f;
        f32v2_t ev = {__builtin_amdgcn_exp2f(tv.x), __builtin_amdgcn_exp2f(tv.y)};
        f32v2_t dv = ev + 1.0f;
        f32v2_t rv = {__builtin_amdgcn_rcpf(dv.x), __builtin_amdgcn_rcpf(dv.y)};
        vv = vv * rv;
        float v0 = vv.x, v1 = vv.y;
        if (cc0 < 256) { xTs[cc0 * 72 + i] = f2bf(v0); xTs[(cc0 + 1) * 72 + i] = f2bf(v1); }
        else if (cc0 < 384) {
          int n = cc0 - 256; unsigned pk = pack2(v0, v1);
          *(unsigned*)(Bs + i * 136 + n) = pk;
          BTs[n * 72 + i] = (bfr)(pk & 0xffffu); BTs[(n + 1) * 72 + i] = (bfr)(pk >> 16);
        } else *(unsigned*)(Cs + i * 136 + (cc0 - 384)) = pack2(v0, v1);
      }
    }
  }
  __syncthreads();
  f32x4 cb[2];
#pragma unroll
  for (int q = 0; q < 2; ++q) {
    int t = w * 2 + q, ti = t >> 2, tj = t & 3;
    cb[q] = f32x4{0.f, 0.f, 0.f, 0.f};
    if (tj <= ti) cb[q] = mma_lds(Cs + ti * 16 * 136, 136, Bs + tj * 16 * 136, 136, 4, cb[q], fr, fq);
  }
#pragma unroll
  for (int it = 0; it < 2; ++it) {
    int e = tid + 512 * it;
    { int i = e >> 4, sg = e & 15; *(u32x4*)(proj + (size_t)(r0 + i) * NIN + 1280 + g * 128 + sg * 8) = *(const u32x4*)(Cs + i * 136 + sg * 8); }
    { int n = e >> 3, sg = e & 7; *(u32x4*)(proj + (size_t)(r0 + (n >> 1)) * NIN + 1024 + g * 128 + (n & 1) * 64 + sg * 8) = *(const u32x4*)(BTs + n * 72 + sg * 8); }
  }
#pragma unroll
  for (int it = 0; it < 4; ++it) {
    int e = tid + 512 * it, xr = e >> 3, sg = e & 7, hh = xr >> 6, pp = xr & 63;
    u32x4 v = *(const u32x4*)(xTs + xr * 72 + sg * 8), o;
#pragma unroll
    for (int k = 0; k < 4; ++k) {
      float e0 = ev[hh * 64 + sg * 8 + 2 * k], e1 = ev[hh * 64 + sg * 8 + 2 * k + 1];
      o[k] = pack2(__uint_as_float(v[k] << 16) * e0, __uint_as_float(v[k] & 0xffff0000u) * e1);
    }
    *(u32x4*)(proj + (size_t)(r0 + pp) * NIN + 512 + (g * 4 + hh) * 64 + sg * 8) = o;
  }
  for (int hh = 0; hh < 4; ++hh) {
    const int h = g * 4 + hh;
    const float Dh = p.in[16][l * 8 + h];
#pragma unroll
    for (int q = 0; q < 2; ++q) {
      int t = w * 2 + q, ti = t >> 2, tj = t & 3, jx = tj * 16 + fr;
      float cj = cumv[hh * 64 + jx], dj = dtv[hh * 64 + jx];
#pragma unroll
      for (int j = 0; j < 4; ++j) {
        int i = ti * 16 + fq * 4 + j;
        float gv = (tj <= ti && jx <= i) ? cb[q][j] * __expf(cumv[hh * 64 + i] - cj) * dj : 0.f;
        Gs[i * 72 + jx] = f2bf(gv);
      }
    }
    __syncthreads();
#pragma unroll
    for (int q = 0; q < 2; ++q) {
      int t = w * 2 + q, ti = t >> 2, tp = t & 3;
      f32x4 a = f32x4{0.f, 0.f, 0.f, 0.f};
      a = mma_lds(Gs + ti * 16 * 72, 72, xTs + (hh * 64 + tp * 16) * 72, 72, 2, a, fr, fq);
      int pp = tp * 16 + fr;
#pragma unroll
      for (int j = 0; j < 4; ++j) {
        int i = ti * 16 + fq * 4 + j;
        float y = a[j] + Dh * bf2f(xTs[(hh * 64 + pp) * 72 + i]);
        mix[(size_t)(r0 + i) * DM + h * 64 + pp] = f2bf(y);
      }
    }
    __syncthreads();
  }
}

__device__ __forceinline__ void store_bf16_asm(bfr* addr, unsigned v) { asm volatile("global_store_short %0, %1, off" :: "v"(addr), "v"(v) : "memory"); }

__device__ void ssd_seq(const KP& p, int l, int s, int h, int ph) {
  extern __shared__ __attribute__((aligned(16))) unsigned char smem[];
  int tid_ = threadIdx.x; asm volatile("" : "+v"(tid_));
  const int tid = tid_, w = tid >> 6, lane = tid & 63, fr = lane & 15, fq = lane >> 4;
  bfr* Sbs = (bfr*)smem;
  const bool prompt = s < 8;
  const int sb = s & 7;
  const int row0 = prompt ? s * PROW : SROW0 + sb * 64;
  const int nch = prompt ? 65 : 1, len = prompt ? PLEN : 64;
  const int g = h >> 2;
  const bfr* proj = (const bfr*)(p.ws + OFF_U);
  const float* cumb = (const float*)(p.ws + OFF_DT);
  bfr* mix = (bfr*)(p.ws + OFF_MIX);
  const int ti = w >> 1, tp = w & 1;
  const int zc = h * 64 + ph * 32 + tp * 16 + fr;

  f32x4 Sacc[2];
#pragma unroll
  for (int pt = 0; pt < 2; ++pt)
#pragma unroll
    for (int j = 0; j < 4; ++j) {
      int pp = pt * 16 + fq * 4 + j, n = 16 * w + fr;
      float v = 0.f;
      if (!prompt) v = p.in[3][((((size_t)l * 8 + sb) * 8 + h) * 64 + ph * 32 + pp) * 128 + n];
      Sacc[pt][j] = v;
      Sbs[pp * 136 + n] = f2bf(v);
    }
  __syncthreads();

  bf16x8 Cs_[2][4], Xs_[2][2][2], Bs_[2][2];
  bfr ys_[2][4], zs_[2][4]; float cus_[2][4], cls_[2];
  const int nB = 16 * w + fr;
#define LBAR() do { asm volatile("s_waitcnt lgkmcnt(0)" ::: "memory"); __builtin_amdgcn_s_barrier(); asm volatile("" ::: "memory"); } while (0)
  const unsigned coff = (unsigned)(((ti * 16 + fr) * NIN + 1280 + g * 128 + fq * 8) * 2);
  unsigned xoff[2];
#pragma unroll
  for (int pt = 0; pt < 2; ++pt) xoff[pt] = (unsigned)(((ph * 32 + pt * 16 + fr) * NIN + 512 + h * 64 + fq * 8) * 2);
  const unsigned boff = (unsigned)((((nB >> 1)) * NIN + 1024 + g * 128 + (nB & 1) * 64 + fq * 8) * 2);
  const unsigned zoff = (unsigned)(((ti * 16 + fq * 4) * NIN + zc) * 2);
  const unsigned yoff = (unsigned)(((ti * 16 + fq * 4) * DM + zc) * 2);
  const unsigned cuoff = (unsigned)(((ti * 16 + fq * 4) * 8 + h) * 4);
#define SSD_LOAD(SET, R0) do { const int _r0 = (R0); \
    const char* _pb = (const char*)proj + (size_t)_r0 * (NIN * 2); \
    const char* _mb = (const char*)mix + (size_t)_r0 * (DM * 2); \
    const char* _cb = (const char*)cumb + (size_t)_r0 * 32; \
    for (int ks = 0; ks < 4; ++ks) Cs_[SET][ks] = *(const bf16x8*)(_pb + coff + ks * 64); \
    for (int pt = 0; pt < 2; ++pt) for (int ks = 0; ks < 2; ++ks) Xs_[SET][pt][ks] = *(const bf16x8*)(_pb + xoff[pt] + ks * 64); \
    for (int ks = 0; ks < 2; ++ks) Bs_[SET][ks] = *(const bf16x8*)(_pb + boff + ks * 64); \
    for (int j = 0; j < 4; ++j) { ys_[SET][j] = *(const bfr*)(_mb + yoff + j * (DM * 2)); zs_[SET][j] = *(const bfr*)(_pb + zoff + j * (NIN * 2)); cus_[SET][j] = *(const float*)(_cb + cuoff + j * 32); } \
    cls_[SET] = *(const float*)(_cb + (63 * 8 + h) * 4); } while (0)
#define SSD_STEP(k, c) do { const int r0 = row0 + (c) * 64; \
    { f32x4 a2 = f32x4{0.f, 0.f, 0.f, 0.f}; \
      a2 = mma_gl(Cs_[k], Sbs + ((k) & 1) * (32 * 136) + tp * 16 * 136, 136, 4, a2, fr, fq); \
      for (int j = 0; j < 4; ++j) { \
        int i = ti * 16 + fq * 4 + j; \
        float y = bf2f(ys_[k][j]) + __expf(cus_[k][j]) * a2[j]; \
        float yz = y * siluf(bf2f(zs_[k][j])); \
        if ((c) * 64 + i >= len) yz = 0.f; \
        store_bf16_asm((bfr*)((char*)mix + (size_t)r0 * (DM * 2) + yoff + j * (DM * 2)), (unsigned)f2bf(yz)); \
      } } \
    { float dec = __expf(cls_[k]); \
      for (int pt = 0; pt < 2; ++pt) { \
        f32x4 a = Sacc[pt]; \
        a[0] *= dec; a[1] *= dec; a[2] *= dec; a[3] *= dec; \
        for (int ks = 0; ks < 2; ++ks) a = __builtin_amdgcn_mfma_f32_16x16x32_bf16(Xs_[k][pt][ks], Bs_[k][ks], a, 0, 0, 0); \
        Sacc[pt] = a; \
        for (int j = 0; j < 4; ++j) Sbs[(((k) + 1) & 1) * (32 * 136) + (pt * 16 + fq * 4 + j) * 136 + 16 * w + fr] = f2bf(a[j]); \
      } } } while (0)
#pragma unroll
  for (int k = 0; k < 2; ++k) SSD_LOAD(k, row0 + min(k, nch - 1) * 64);
  int c0 = 0;
  for (; c0 + 1 < nch; c0 += 2) {
#pragma unroll
    for (int k = 0; k < 2; ++k) {
      const int c = c0 + k;
      SSD_STEP(k, c);
      SSD_LOAD(k, row0 + min(c + 2, nch - 1) * 64);
      LBAR();
    }
  }
  if (c0 < nch) { SSD_STEP(0, c0); LBAR(); }
#undef SSD_STEP
#undef LBAR
#undef SSD_LOAD
  float* so = p.out + (prompt ? O_SP : O_SS) + (((size_t)l * 8 + sb) * 8 + h) * 64 * 128;
#pragma unroll
  for (int pt = 0; pt < 2; ++pt)
#pragma unroll
    for (int j = 0; j < 4; ++j) so[(size_t)(ph * 32 + pt * 16 + fq * 4 + j) * 128 + 16 * w + fr] = Sacc[pt][j];
}

__device__ __forceinline__ void gla_pre(const KP& p, int l, int sbid, int h, bfr (&qn)[8], bfr (&fn)[8], u32x4& vv, bool have, bool want_next) {
  extern __shared__ __attribute__((aligned(16))) unsigned char smem[];
  int tid_ = threadIdx.x; asm volatile("" : "+v"(tid_));
  const int tid = tid_, w = tid >> 6, lane = tid & 63, fr = lane & 15, fq = lane >> 4;
  bfr* qes = (bfr*)smem;
  bfr* kes = qes + 32 * 136;
  bfr* kdTs = kes + 32 * 136;
  bfr* vTs = kdTs + 128 * 40;
  bfr* atts = vTs + 128 * 40;
  float* segs = (float*)(atts + 32 * 40);

  int r0, pos0, len;
  if (sbid < 1040) { int s = sbid / 130, st = sbid % 130; r0 = s * PROW + st * 32; pos0 = st * 32; len = PLEN; }
  else { int x = sbid - 1040; r0 = SROW0 + x * 32; pos0 = (x & 1) * 32; len = 64; }
  bfr* proj = (bfr*)(p.ws + OFF_U);
  bfr* mix = (bfr*)(p.ws + OFF_MIX);
  float* decb = (float*)(p.ws + OFF_DEC);
  const int kk_ = tid & 127, seg = tid >> 7;
  float lb = 0.f;
  if (l == 1) {
    float d = p.in[18][512 + h * 128 + kk_] - p.in[18][h * 128 + kk_];
    lb = fminf(__fdividef(1.f, 1.f + __expf(-d)), 1.f - 1e-6f);
  }
  float qv[8], kv[8], cm[8];
#define GLAPRE_LOAD(H) do { \
    for (int it = 0; it < 8; ++it) { size_t rb = (size_t)(r0 + seg * 8 + it) * NIN; \
      qn[it] = proj[rb + 1536 + (H) * 128 + kk_]; fn[it] = proj[rb + 2048 + (H) * 128 + kk_]; } \
    { int j = tid >> 4, sg = tid & 15; vv = *(const u32x4*)(proj + (size_t)(r0 + j) * NIN + 2560 + (H) * 128 + sg * 8); } } while (0)
  if (!have) GLAPRE_LOAD(h);
  {
    float run = 0.f;
#pragma unroll
    for (int it = 0; it < 8; ++it) {
      int j = seg * 8 + it;
      float hq = bf2f(qn[it]), fx = bf2f(fn[it]);
      qv[it] = siluf(hq);
      float ex_ = __expf(fx);
      float sg_ = __fdividef(1.f, 1.f + ex_);
      float kkv = (1.f - lb) * sg_;
      float fsel = (kkv < 0.5f) ? (1.f - kkv) : fmaxf(lb + (1.f - lb) * ex_ * sg_, 1e-30f);
      float lf = __logf(fsel);
      if (pos0 + j >= len) { kkv = 0.f; lf = 0.f; }
      kv[it] = kkv;
      run += lf; cm[it] = run;
    }
    segs[seg * 128 + kk_] = run;
    { int j = tid >> 4, sg = tid & 15;
#pragma unroll
      for (int k = 0; k < 4; ++k) { vTs[(sg * 8 + 2 * k) * 40 + j] = (bfr)(vv[k] & 0xffffu); vTs[(sg * 8 + 2 * k + 1) * 40 + j] = (bfr)(vv[k] >> 16); } }
  }
  __syncthreads();
  if (want_next) GLAPRE_LOAD(h + 1);
#undef GLAPRE_LOAD
  {
    float s0 = segs[kk_], s1 = segs[128 + kk_], s2 = segs[256 + kk_], s3 = segs[384 + kk_];
    float base = (seg > 0 ? s0 : 0.f) + (seg > 1 ? s1 : 0.f) + (seg > 2 ? s2 : 0.f);
    float cl = s0 + s1 + s2 + s3;
    const float ecl = __expf(cl);
    if (seg == 0) decb[((size_t)sbid * 4 + h) * 128 + kk_] = ecl;
#pragma unroll
    for (int it = 0; it < 8; ++it) {
      int j = seg * 8 + it;
      float c = base + cm[it];
      float en = __expf(-c), kn = kv[it] * en;
      qes[j * 136 + kk_] = f2bf(qv[it] * __expf(c));
      kes[j * 136 + kk_] = f2bf(kn);
      kdTs[kk_ * 40 + j] = f2bf(kn * ecl);
    }
  }
  asm volatile("s_waitcnt lgkmcnt(0)" ::: "memory"); __builtin_amdgcn_s_barrier(); asm volatile("" ::: "memory");
  if (w < 4) {
    int ti = w >> 1, tj = w & 1;
    f32x4 a = f32x4{0.f, 0.f, 0.f, 0.f};
    if (tj <= ti) a = mma_lds(qes + ti * 16 * 136, 136, kes + tj * 16 * 136, 136, 4, a, fr, fq);
    int jx = tj * 16 + fr;
#pragma unroll
    for (int j = 0; j < 4; ++j) {
      int i = ti * 16 + fq * 4 + j;
      atts[i * 40 + jx] = f2bf((tj <= ti && jx <= i) ? a[j] : 0.f);
    }
  }
  { int j = tid >> 4, sg = tid & 15; *(u32x4*)(proj + (size_t)(r0 + j) * NIN + 1536 + h * 128 + sg * 8) = *(const u32x4*)(qes + j * 136 + sg * 8); }
  { int k = tid >> 2, sg = tid & 3;
    *(u32x4*)(proj + (size_t)(r0 + (k >> 2)) * NIN + 2048 + h * 128 + (k & 3) * 32 + sg * 8) = *(const u32x4*)(kdTs + k * 40 + sg * 8);
    *(u32x4*)(proj + (size_t)(r0 + (k >> 2)) * NIN + 2560 + h * 128 + (k & 3) * 32 + sg * 8) = *(const u32x4*)(vTs + k * 40 + sg * 8); }
  asm volatile("s_waitcnt lgkmcnt(0)" ::: "memory"); __builtin_amdgcn_s_barrier(); asm volatile("" ::: "memory");
#pragma unroll
  for (int q = 0; q < 2; ++q) {
    int t = w * 2 + q, ti = t >> 3, tv = t & 7;
    f32x4 a = f32x4{0.f, 0.f, 0.f, 0.f};
    a = mma_lds(atts + ti * 16 * 40, 40, vTs + tv * 16 * 40, 40, 1, a, fr, fq);
#pragma unroll
    for (int j = 0; j < 4; ++j) {
      int i = ti * 16 + fq * 4 + j;
      mix[(size_t)(r0 + i) * DM + 512 + h * 128 + tv * 16 + fr] = f2bf(a[j]);
    }
  }
  asm volatile("s_waitcnt lgkmcnt(0)" ::: "memory"); __builtin_amdgcn_s_barrier(); asm volatile("" ::: "memory");
}

__device__ void gla_seq(const KP& p, int l, int s, int h, int vq) {
  extern __shared__ __attribute__((aligned(16))) unsigned char smem[];
  int tid_ = threadIdx.x; asm volatile("" : "+v"(tid_));
  const int tid = tid_, w = tid >> 6, lane = tid & 63, fr = lane & 15, fq = lane >> 4;
  bfr* STs = (bfr*)smem;
  const bool prompt = s < 8;
  const int sb = s & 7;
  const int row0 = prompt ? s * PROW : SROW0 + sb * 64;
  const int nst = prompt ? 130 : 2, len = prompt ? PLEN : 64;
  const int sbid0 = prompt ? s * 130 : 1040 + sb * 2;
  const bfr* proj = (const bfr*)(p.ws + OFF_U);
  const float* decb = (const float*)(p.ws + OFF_DEC);
  bfr* mix = (bfr*)(p.ws + OFF_MIX);
  const int ti = (w >> 1) & 1, tv = w & 1;
  const int oc = 512 + h * 128 + vq * 32 + tv * 16 + fr;

  f32x4 Sacc[2];
#pragma unroll
  for (int vt = 0; vt < 2; ++vt)
#pragma unroll
    for (int j = 0; j < 4; ++j) {
      int k = 16 * w + fq * 4 + j, v = vt * 16 + fr;
      float x = 0.f;
      if (!prompt) x = p.in[4][((((size_t)l * 8 + sb) * 4 + h) * 128 + k) * 128 + vq * 32 + v];
      Sacc[vt][j] = x;
      STs[v * 136 + k] = f2bf(x);
    }
  __syncthreads();

  bf16x8 Qs[4][4], Ks[4], Vs[4][2];
  bfr os_[4][4]; float ds_[4][4];
  const int kA = 16 * w + fr;
#define LBAR() do { asm volatile("s_waitcnt lgkmcnt(0)" ::: "memory"); __builtin_amdgcn_s_barrier(); asm volatile("" ::: "memory"); } while (0)
  const unsigned qoff = (unsigned)(((ti * 16 + fr) * NIN + 1536 + h * 128 + fq * 8) * 2);
  const unsigned koff = (unsigned)((((kA >> 2)) * NIN + 2048 + h * 128 + (kA & 3) * 32 + fq * 8) * 2);
  unsigned voff[2];
#pragma unroll
  for (int vt = 0; vt < 2; ++vt) { int _v = vq * 32 + vt * 16 + fr; voff[vt] = (unsigned)(((_v >> 2) * NIN + 2560 + h * 128 + (_v & 3) * 32 + fq * 8) * 2); }
  const unsigned ooff = (unsigned)(((ti * 16 + fq * 4) * DM + oc) * 2);
  const unsigned doff = (unsigned)((h * 128 + 16 * w + fq * 4) * 4);
#define GLA_LOAD(SET, ST) do { const int _st = (ST); \
    const char* _pb = (const char*)proj + (size_t)(row0 + _st * 32) * (NIN * 2); \
    const char* _mb = (const char*)mix + (size_t)(row0 + _st * 32) * (DM * 2); \
    const char* _db = (const char*)decb + (size_t)(sbid0 + _st) * (4 * 128 * 4); \
    for (int ks = 0; ks < 4; ++ks) Qs[SET][ks] = *(const bf16x8*)(_pb + qoff + ks * 64); \
    for (int j = 0; j < 4; ++j) os_[SET][j] = *(const bfr*)(_mb + ooff + j * (DM * 2)); \
    Ks[SET] = *(const bf16x8*)(_pb + koff); \
    for (int vt = 0; vt < 2; ++vt) Vs[SET][vt] = *(const bf16x8*)(_pb + voff[vt]); \
    { const f32x4 _d = *(const f32x4*)(_db + doff); ds_[SET][0] = _d[0]; ds_[SET][1] = _d[1]; ds_[SET][2] = _d[2]; ds_[SET][3] = _d[3]; } } while (0)
#define GLA_STEP(k, st) do { const int r0 = row0 + (st) * 32; \
    if (w < 4) { \
      f32x4 a = f32x4{0.f, 0.f, 0.f, 0.f}; \
      a = mma_gl(Qs[k], STs + ((k) & 1) * (32 * 136) + tv * 16 * 136, 136, 4, a, fr, fq); \
      for (int j = 0; j < 4; ++j) { \
        int i = ti * 16 + fq * 4 + j; \
        float o = bf2f(os_[k][j]) + a[j]; \
        if ((st) * 32 + i >= len) o = 0.f; \
        store_bf16_asm((bfr*)((char*)mix + (size_t)r0 * (DM * 2) + ooff + j * (DM * 2)), (unsigned)f2bf(o)); \
      } \
    } \
    for (int vt = 0; vt < 2; ++vt) { \
      f32x4 a = Sacc[vt]; \
      for (int j = 0; j < 4; ++j) a[j] *= ds_[k][j]; \
      a = __builtin_amdgcn_mfma_f32_16x16x32_bf16(Ks[k], Vs[k][vt], a, 0, 0, 0); \
      Sacc[vt] = a; \
      for (int j = 0; j < 4; ++j) STs[(((k) + 1) & 1) * (32 * 136) + (vt * 16 + fr) * 136 + 16 * w + fq * 4 + j] = f2bf(a[j]); \
    } } while (0)
#pragma unroll
  for (int k = 0; k < 4; ++k) GLA_LOAD(k, min(k, nst - 1));
  int st0 = 0;
  for (; st0 + 3 < nst; st0 += 4) {
#pragma unroll
    for (int k = 0; k < 4; ++k) {
      const int st = st0 + k;
      GLA_STEP(k, st);
      GLA_LOAD(k, min(st + 4, nst - 1));
      LBAR();
    }
  }
#pragma unroll
  for (int k = 0; k < 4; ++k) {
    const int st = st0 + k;
    if (st < nst) { GLA_STEP(k, st); LBAR(); }
  }
#undef GLA_STEP
#undef LBAR
#undef GLA_LOAD
  float* so = p.out + (prompt ? O_HP : O_HS) + (((size_t)l * 8 + sb) * 4 + h) * 128 * 128;
#pragma unroll
  for (int vt = 0; vt < 2; ++vt)
#pragma unroll
    for (int j = 0; j < 4; ++j) so[(size_t)(16 * w + fq * 4 + j) * 128 + vq * 32 + vt * 16 + fr] = Sacc[vt][j];
}

__device__ void phase_pre(const KP& p, int l) {
  for (int u = p.bid; u < 1056; u += p.nblk) ssd_pre(p, l, u >> 1, u & 1);
  int lo, hi;
  if (p.nblk == 256) { if (p.bid < 32) { lo = p.bid * 13; hi = lo + 13; } else { lo = 416 + (p.bid - 32) * 17; hi = lo + 17; } }
  else { lo = (int)((long)4224 * p.bid / p.nblk); hi = (int)((long)4224 * (p.bid + 1) / p.nblk); }
  bfr qn[8], fn[8]; u32x4 vv;
  for (int v = lo; v < hi; ++v) {
    const bool have = (v > lo) && ((v & 3) != 0);
    const bool want = (v + 1 < hi) && (((v + 1) & 3) != 0);
    gla_pre(p, l, v >> 2, v & 3, qn, fn, vv, have, want);
  }
}

__device__ void phase_seq(const KP& p, int l) {
  for (int u = p.bid; u < 512; u += p.nblk) {
    int uu = u & 255, soff = (u >= 256) ? 8 : 0;
    if (uu < 128) ssd_seq(p, l, soff + (uu >> 4), (uu & 15) >> 1, uu & 1);
    else { int v = uu - 128; gla_seq(p, l, soff + (v >> 4), (v & 15) >> 2, v & 3); }
    __syncthreads();
  }
}


#define XB_TMO      128
#define XB_XCNT(j)  (256  + 64 * (j))
#define XB_XSUB(j)  (1280 + 64 * (j))
#define XB_XGEN(j)  (2304 + 64 * (j))
#define XB_TOP      3328
#define XB_TOPGEN   3392
#define XCD_BAR_WORDS 3456
#define XB_SPIN_CAP (1u << 18)
#define LAS __attribute__((address_space(3)))
__device__ __forceinline__ unsigned xb_ld(unsigned* p)              { return __hip_atomic_load(p, __ATOMIC_RELAXED, __HIP_MEMORY_SCOPE_AGENT); }
__device__ __forceinline__ unsigned xb_add(unsigned* p, unsigned v) { return __hip_atomic_fetch_add(p, v, __ATOMIC_RELAXED, __HIP_MEMORY_SCOPE_AGENT); }
__device__ __forceinline__ unsigned xb_xcc_id() { return (unsigned)__builtin_amdgcn_s_getreg((3 << 11) | 20) & 0xFu; }
#define XB_SPIN(cond, bar) do { unsigned _sp = 0; while (cond) { __builtin_amdgcn_s_sleep(1); \
    if ((++_sp & 255u) == 0u) { if (xb_ld(&(bar)[XB_TMO])) break; if (_sp > XB_SPIN_CAP) { atomicAdd(&(bar)[XB_TMO], 1u); break; } } } } while (0)
struct XcdBarrier { unsigned* bar; unsigned x; volatile LAS unsigned* st; };
__device__ __forceinline__ XcdBarrier xcd_barrier_post(unsigned* bar, volatile LAS unsigned* st) {
  XcdBarrier b; b.bar = bar; b.x = xb_xcc_id(); b.st = st;
  if (threadIdx.x == 0) (void)xb_add(&bar[XB_XCNT(b.x)], 1u);
  return b;
}
__device__ __forceinline__ void xcd_barrier_complete(unsigned* bar, unsigned x, unsigned& nloc, unsigned& nx) {
  const unsigned G = gridDim.x * gridDim.y * gridDim.z;
  unsigned sum, cnt, mine, sp = 0u;
  for (;;) {
    sum = 0u; cnt = 0u; mine = 0u;
#pragma unroll
    for (unsigned j = 0; j < 16; ++j) { const unsigned c = xb_ld(&bar[XB_XCNT(j)]); sum += c; cnt += (c > 0u) ? 1u : 0u; mine = (j == x) ? c : mine; }
    if (sum == G) break;
    __builtin_amdgcn_s_sleep(1);
    if ((++sp & 255u) == 0u) { if (xb_ld(&bar[XB_TMO])) break; if (sp > XB_SPIN_CAP) { atomicAdd(&bar[XB_TMO], 1u); break; } }
  }
  nloc = mine > 0u ? mine : 1u; nx = cnt > 0u ? cnt : 1u;
}
__device__ __forceinline__ void xcd_barrier(const XcdBarrier& b) {
  asm volatile("s_waitcnt vmcnt(0)" ::: "memory");
  __syncthreads();
  if (threadIdx.x == 0) {
    unsigned* bar = b.bar; asm volatile("" : "+s"(bar));
    __builtin_amdgcn_s_waitcnt(0);
    unsigned nloc = b.st[0], nx = b.st[1];
    if (nloc == 0u) { xcd_barrier_complete(bar, b.x, nloc, nx); b.st[0] = nloc; b.st[1] = nx; }
    const unsigned old = xb_add(&bar[XB_XSUB(b.x)], 1u);
    const unsigned gen = old / nloc;
    if (old + 1u == (gen + 1u) * nloc) {
      __builtin_amdgcn_fence(__ATOMIC_RELEASE, "agent");
      asm volatile("s_waitcnt vmcnt(0)" ::: "memory");
      const unsigned og = xb_add(&bar[XB_TOP], 1u);
      const unsigned tg = og / nx;
      if (og + 1u == (tg + 1u) * nx) xb_add(&bar[XB_TOPGEN], 1u);
      else XB_SPIN(xb_ld(&bar[XB_TOPGEN]) == tg, bar);
      __builtin_amdgcn_fence(__ATOMIC_ACQUIRE, "agent");
      xb_add(&bar[XB_XGEN(b.x)], 1u);
      asm volatile("s_waitcnt vmcnt(0)" ::: "memory");
    } else {
      XB_SPIN(xb_ld(&bar[XB_XGEN(b.x)]) == gen, bar);
      __builtin_amdgcn_fence(__ATOMIC_ACQUIRE, "agent");
      asm volatile("s_waitcnt vmcnt(0)" ::: "memory");
    }
  }
  __syncthreads();
}

__device__ void run_phase(const KP& p_, int ph) {
  KP p = p_;
  {
    unsigned long long w_ = (unsigned long long)p_.ws, o_ = (unsigned long long)p_.out;
    unsigned wl = __builtin_amdgcn_readfirstlane((unsigned)w_), wh = __builtin_amdgcn_readfirstlane((unsigned)(w_ >> 32));
    unsigned ol = __builtin_amdgcn_readfirstlane((unsigned)o_), oh = __builtin_amdgcn_readfirstlane((unsigned)(o_ >> 32));
    int b_ = __builtin_amdgcn_readfirstlane((int)blockIdx.x), n_ = __builtin_amdgcn_readfirstlane((int)gridDim.x);
    asm volatile("" : "+s"(wl), "+s"(wh), "+s"(ol), "+s"(oh), "+s"(b_), "+s"(n_));
    p.ws = (unsigned char*)(__attribute__((address_space(1))) unsigned char*)(((unsigned long long)wh << 32) | (unsigned long long)wl);
    p.out = (float*)(__attribute__((address_space(1))) float*)(((unsigned long long)oh << 32) | (unsigned long long)ol);
    p.bid = b_; p.nblk = n_;
  }
  const bfr* W = (const bfr*)(p.ws + OFF_W);
  const bfr* hb = (const bfr*)(p.ws + OFF_HB);
  const bfr* U = (const bfr*)(p.ws + OFF_U);
  const bfr* mix = (const bfr*)(p.ws + OFF_MIX);
  int plo = 0, phi = 0, pfirst = 16;
  if (ph == 0) { phi = 1408; pfirst = 0; }
  else {
    int l = (ph - 1) / 12, q = (ph - 1) % 12;
    const bfr* Wl = W + (size_t)l * W_LAYER;
    if (q == 2 || q == 8 || (q == 11 && l == 0)) { phase_stat(p); return; }
    if (q == 11) { phase_final(p); return; }
    if (q == 4) { phase_pre(p, l); return; }
    if (q == 5) { phase_seq(p, l); return; }
    if (q == 6) { phase_mixnorm(p, l); return; }
    if (q == 0) { gemm_phase<1, NGU, DM>(p, l, hb, Wl + W_GUA); if (l == 0) { plo = 1408; phi = 2112; pfirst = (132 * 22) % p.nblk; } }
    else if (q == 1) { gemm_phase<2, DM, DFF>(p, l, U, Wl + W_DA); if (l == 0) { plo = 2112; phi = 5440; } else { plo = 7552; phi = 10880; } }
    else if (q == 3) gemm_phase<3, NINP, DM>(p, l, hb, Wl + W_IN);
    else if (q == 7) { gemm_phase<2, DM, DM>(p, l, mix, Wl + W_OUT); if (l == 0) { plo = 5440; phi = 6140; } }
    else if (q == 9) gemm_phase<1, NGU, DM>(p, l, hb, Wl + W_GUB);
    else { gemm_phase<2, DM, DFF>(p, l, U, Wl + W_DB); if (l == 0) { plo = 6140; phi = 7552; } }
  }
  if (phi > plo) { __syncthreads(); phase_prep(p, plo, phi, pfirst); }
  if (ph == 0) phase_init(p);
}

__global__ void __launch_bounds__(512, 2) hymba_fwd(KP p) {
  extern __shared__ __attribute__((aligned(16))) unsigned char smem[];
  volatile LAS unsigned* st = (volatile LAS unsigned*)(smem + 131072);
  if (threadIdx.x == 0) { st[0] = 0u; st[1] = 0u; }
  __syncthreads();
  XcdBarrier xb = xcd_barrier_post((unsigned*)(p.ws + OFF_BAR), st);
  for (int ph = p.ph_lo; ph < p.ph_hi; ++ph) {
    run_phase(p, ph);
    if (ph + 1 < p.ph_hi) { if (ph < 0) cg::this_grid().sync(); else xcd_barrier(xb); }
  }
}

extern "C" void kernel_launch(void* const* d_in, const int* in_sizes, int n_in, void* d_out, int out_size,
                              void* d_ws, size_t ws_size, hipStream_t stream) {
  static int grid = 0;
  if (!grid) {
    int dev = 0, cus = 0, per_cu = 0;
    hipGetDevice(&dev);
    hipDeviceGetAttribute(&cus, hipDeviceAttributeMultiprocessorCount, dev);
    hipFuncSetAttribute((const void*)hymba_fwd, hipFuncAttributeMaxDynamicSharedMemorySize, LDS_BYTES);
    hipOccupancyMaxActiveBlocksPerMultiprocessor(&per_cu, (const void*)hymba_fwd, 512, LDS_BYTES);
    if (per_cu < 1) per_cu = 1;
    grid = cus * per_cu;
    if (grid > 256) grid = 256;
  }
  hipMemsetAsync((char*)d_ws + OFF_BAR, 0, XCD_BAR_WORDS * 4, stream);
  KP p{};
  for (int i = 0; i < 26; ++i) p.in[i] = (const float*)d_in[i];
  p.out = (float*)d_out; p.ws = (unsigned char*)d_ws;
#if SINGLE_LAUNCH
  p.ph_lo = 0; p.ph_hi = NPHASE;
  void* args[] = {&p};
  hipError_t e = hipLaunchCooperativeKernel((const void*)hymba_fwd, dim3(grid), dim3(512), args, LDS_BYTES, stream);
  if (e != hipSuccess) fprintf(stderr, "cooperative launch failed: %s (grid %d)\n", hipGetErrorString(e), grid);
#else
  for (int ph = 0; ph < NPHASE; ++ph) {
    p.ph_lo = ph; p.ph_hi = ph + 1;
    hipLaunchKernelGGL(hymba_fwd, dim3(grid), dim3(512), LDS_BYTES, stream, p);
  }
#endif
}
```

```cpp
#include <hip/hip_runtime.h>
#include <hip/hip_bf16.h>
#include <hip/hip_cooperative_groups.h>
#include <cstdio>
namespace cg = cooperative_groups;

#ifndef SINGLE_LAUNCH
#define SINGLE_LAUNCH 1
#endif

typedef unsigned short bfr;
using bf16x8 = __attribute__((ext_vector_type(8))) short;
using f32x4  = __attribute__((ext_vector_type(4))) float;
using u32x4  = __attribute__((ext_vector_type(4))) unsigned;

constexpr int T_ROWS = 33792;
constexpr int PROW = 4160, PLEN = 4112, SROW0 = 33280;
constexpr int DM = 1024, DFF = 2816, NGU = 5632, NIN = 3584, NINP = 3840;
constexpr float EPSF = 1e-6f;
constexpr size_t OFF_HB = 0;
constexpr size_t OFF_RS = 69206016;
constexpr size_t OFF_DT = 69341184;
constexpr size_t OFF_U = 70422528;
constexpr size_t OFF_MIX = 312643584;
constexpr size_t OFF_W = 381849600;
constexpr size_t W_GUA = 0, W_DA = 5767168, W_IN = 8650752, W_OUT = 12582912, W_GUB = 13631488, W_DB = 19398656, W_LAYER = 22282240;
constexpr size_t O_YP = 0, O_YS = 33554432, O_CP = 34078720, O_SP = 34127872, O_HP = 35176448, O_CS = 36225024, O_SS = 36274176, O_HS = 37322752;
constexpr size_t OFF_TAILS = 470978560;
constexpr size_t OFF_DEC = 474222592;
constexpr size_t OFF_BAR = 476385280;
constexpr int LDS_BYTES = 131072 + 16;
constexpr int NPHASE = 25;

struct KP {
  const float* in[26];
  float* out;
  unsigned char* ws;
  int ph_lo, ph_hi;
  int bid, nblk;
};

typedef __bf16 bf16v2_t __attribute__((ext_vector_type(2)));
typedef float f32v2_t __attribute__((ext_vector_type(2)));
__device__ __forceinline__ unsigned pack2(float a, float b) { f32v2_t v = {a, b}; bf16v2_t r = __builtin_convertvector(v, bf16v2_t); return __builtin_bit_cast(unsigned, r); }
__device__ __forceinline__ bfr f2bf(float f) { return (bfr)(pack2(f, f) & 0xffffu); }
__device__ __forceinline__ float bf2f(bfr b) { return __uint_as_float(((unsigned)b) << 16); }
__device__ __forceinline__ float siluf(float x) { return x * __builtin_amdgcn_rcpf(1.f + __builtin_amdgcn_exp2f(x * -1.44269504f)); }

struct PrepMeta { int l, K, n0, k0; size_t woff; };
__device__ __forceinline__ void prep_load(const KP& p, int job, int tid, float (&v)[8], PrepMeta& m) {
  int l = job / 5440, j = job % 5440;
  int mat, nt, kt, K; size_t woff;
  const float *s0, *s1, *sc; int ldn; float cs;
  if (j < 1408) { mat = 0; nt = j / 16; kt = j % 16; K = DM; woff = W_GUA; s0 = p.in[7] + (size_t)l * DM * DFF; s1 = p.in[8] + (size_t)l * DM * DFF; sc = p.in[6] + l * DM; ldn = DFF; cs = 1.f; }
  else if (j < 2112) { j -= 1408; mat = 1; nt = j / 44; kt = j % 44; K = DFF; woff = W_DA; s0 = s1 = p.in[9] + (size_t)l * DFF * DM; sc = nullptr; ldn = DM; cs = 0.5f; }
  else if (j < 3072) { j -= 2112; mat = 2; nt = j / 16; kt = j % 16; K = DM; woff = W_IN; s0 = s1 = p.in[11] + (size_t)l * DM * 3592; sc = p.in[10] + l * DM; ldn = 3592; cs = 1.f; }
  else if (j < 3328) { j -= 3072; mat = 3; nt = j / 16; kt = j % 16; K = DM; woff = W_OUT; s0 = s1 = p.in[20] + (size_t)l * DM * DM; sc = nullptr; ldn = DM; cs = 1.f; }
  else if (j < 4736) { j -= 3328; mat = 0; nt = j / 16; kt = j % 16; K = DM; woff = W_GUB; s0 = p.in[22] + (size_t)l * DM * DFF; s1 = p.in[23] + (size_t)l * DM * DFF; sc = p.in[21] + l * DM; ldn = DFF; cs = 1.f; }
  else { j -= 4736; mat = 1; nt = j / 44; kt = j % 44; K = DFF; woff = W_DB; s0 = s1 = p.in[24] + (size_t)l * DFF * DM; sc = nullptr; ldn = DM; cs = 0.5f; }
  const int n0 = nt * 64, k0 = kt * 64;
  m.l = l; m.K = K; m.n0 = n0; m.k0 = k0; m.woff = woff;
#pragma unroll
  for (int it = 0; it < 8; ++it) {
    int e = tid + 512 * it, kk = e >> 6, nn = e & 63;
    int k = k0 + kk, n = n0 + nn, c; bool ok = true; const float* sp = s0;
    const int nl = n & 255, bj = nl >> 7, wc_ = (nl >> 5) & 3, ns = (nl >> 4) & 1, r = nl & 15;
    if (mat == 0) { c = (n >> 8) * 128 + wc_ * 32 + (r >> 2) * 8 + bj * 4 + (r & 3); if (ns) sp = s1; }
    else {
      c = (n & ~255) + bj * 128 + wc_ * 32 + (r >> 2) * 8 + ns * 4 + (r & 3);
      if (mat == 2) { if (c < 1536) c = c; else if (c < 3584) c = c + 8; else if (c < 3592) c = 1536 + (c - 3584); else { ok = false; c = 0; } }
    }
    float x = sp[(size_t)k * ldn + c] * cs;
    if (sc) x *= sc[k];
    v[it] = ok ? x : 0.f;
  }
}
__device__ __forceinline__ void prep_tile_out(bfr* W, const float* tile, int tid, const float (&v)[8], const PrepMeta& m) {
#pragma unroll
  for (int it = 0; it < 8; ++it) { int e = tid + 512 * it; ((float*)tile)[(e >> 6) * 65 + (e & 63)] = v[it]; }
}
__device__ void phase_prep(const KP& p, int job_lo, int job_hi, int first_blk) {
  extern __shared__ __attribute__((aligned(16))) unsigned char smem[];
  int tid = threadIdx.x; asm volatile("" : "+v"(tid));
  bfr* W = (bfr*)(p.ws + OFF_W);
  const int total = (p.bid < first_blk) ? 0 : job_hi, stride = p.nblk - first_blk;
  float va[8], vb[8]; PrepMeta ma, mb;
  const int j0 = job_lo + (p.bid - first_blk);
  if (j0 < total) prep_load(p, j0, tid, va, ma);
  if (j0 + stride < total) prep_load(p, j0 + stride, tid, vb, mb);
  int buf = 0;
  for (int job = j0; job < total; job += 2 * stride) {
#pragma unroll
    for (int half = 0; half < 2; ++half) {
      const int jb = job + half * stride;
      if (jb < total) {
        float* tile = (float*)smem + buf * (64 * 65);
        PrepMeta mc = half ? mb : ma;
        if (half == 0) prep_tile_out(W, tile, tid, va, ma); else prep_tile_out(W, tile, tid, vb, mb);
        __syncthreads();
        if (jb + 2 * stride < total) { if (half == 0) prep_load(p, jb + 2 * stride, tid, va, ma); else prep_load(p, jb + 2 * stride, tid, vb, mb); }
        {
          int nn = tid >> 3, seg = tid & 7;
          u32x4 v;
          v[0] = pack2(tile[(seg * 8 + 0) * 65 + nn], tile[(seg * 8 + 1) * 65 + nn]);
          v[1] = pack2(tile[(seg * 8 + 2) * 65 + nn], tile[(seg * 8 + 3) * 65 + nn]);
          v[2] = pack2(tile[(seg * 8 + 4) * 65 + nn], tile[(seg * 8 + 5) * 65 + nn]);
          v[3] = pack2(tile[(seg * 8 + 6) * 65 + nn], tile[(seg * 8 + 7) * 65 + nn]);
          *(u32x4*)(W + (size_t)mc.l * W_LAYER + mc.woff + (size_t)(mc.n0 + nn) * mc.K + mc.k0 + seg * 8) = v;
        }
        buf ^= 1;
      }
    }
  }
  __syncthreads();
}

__device__ __forceinline__ float wave_sum(float v) {
#pragma unroll
  for (int o = 32; o >= 1; o >>= 1) v += __shfl_xor(v, o);
  return v;
}

__device__ void phase_init(const KP& p) {
  int tid_ = threadIdx.x; asm volatile("" : "+v"(tid_));
  const int lane = tid_ & 63, w = tid_ >> 6;
  bfr* hb = (bfr*)(p.ws + OFF_HB);
  float* rs = (float*)(p.ws + OFF_RS);
  for (int row = p.bid * 8 + w; row < T_ROWS; row += p.nblk * 8) {
    const float* src = nullptr;
    if (row < SROW0) {
      int s = row / PROW, pos = row % PROW;
      if (pos < 16) src = p.in[5] + (size_t)pos * DM;
      else if (pos < PLEN) src = p.in[0] + ((size_t)s * 4096 + (pos - 16)) * DM;
    } else src = p.in[1] + (size_t)(row - SROW0) * DM;
    float ss = 0.f;
#pragma unroll
    for (int i = 0; i < 4; ++i) {
      int c = 4 * (lane + 64 * i);
      float4 v = src ? *(const float4*)(src + c) : make_float4(0.f, 0.f, 0.f, 0.f);
      bfr b0 = f2bf(v.x), b1 = f2bf(v.y), b2 = f2bf(v.z), b3 = f2bf(v.w);
      float r0 = bf2f(b0), r1 = bf2f(b1), r2 = bf2f(b2), r3 = bf2f(b3);
      ss += r0 * r0 + r1 * r1 + r2 * r2 + r3 * r3;
      uint2 o; o.x = (unsigned)b0 | ((unsigned)b1 << 16); o.y = (unsigned)b2 | ((unsigned)b3 << 16);
      *(uint2*)(hb + (size_t)row * DM + c) = o;
    }
    ss = wave_sum(ss);
    if (lane == 0) rs[row] = rsqrtf(ss * (1.f / DM) + EPSF);
  }
}

__device__ void phase_stat(const KP& p) {
  int tid_ = threadIdx.x; asm volatile("" : "+v"(tid_));
  const int lane = tid_ & 63, w = tid_ >> 6;
  const bfr* hb = (const bfr*)(p.ws + OFF_HB);
  float* rs = (float*)(p.ws + OFF_RS);
  for (int row = p.bid * 8 + w; row < T_ROWS; row += p.nblk * 8) {
    float ss = 0.f;
#pragma unroll
    for (int i = 0; i < 2; ++i) {
      u32x4 v = *(const u32x4*)(hb + (size_t)row * DM + lane * 8 + 512 * i);
#pragma unroll
      for (int e = 0; e < 4; ++e) {
        float a = __uint_as_float(v[e] << 16), b = __uint_as_float(v[e] & 0xffff0000u);
        ss += a * a + b * b;
      }
    }
    ss = wave_sum(ss);
    if (lane == 0) rs[row] = rsqrtf(ss * (1.f / DM) + EPSF);
  }
}

__device__ void phase_final(const KP& p) {
  int tid_ = threadIdx.x; asm volatile("" : "+v"(tid_));
  const int lane = tid_ & 63, w = tid_ >> 6;
  const bfr* hb = (const bfr*)(p.ws + OFF_HB);
  const float* lw = p.in[25];
  for (int row = p.bid * 8 + w; row < T_ROWS; row += p.nblk * 8) {
    float* dst;
    if (row < SROW0) {
      int s = row / PROW, pos = row % PROW;
      if (pos < 16 || pos >= PLEN) continue;
      dst = p.out + O_YP + ((size_t)s * 4096 + (pos - 16)) * DM;
    } else dst = p.out + O_YS + (size_t)(row - SROW0) * DM;
    float x[16];
    float ss = 0.f;
#pragma unroll
    for (int i = 0; i < 2; ++i) {
      u32x4 v = *(const u32x4*)(hb + (size_t)row * DM + lane * 8 + 512 * i);
#pragma unroll
      for (int e = 0; e < 4; ++e) {
        float a = __uint_as_float(v[e] << 16), b = __uint_as_float(v[e] & 0xffff0000u);
        x[i * 8 + e * 2] = a; x[i * 8 + e * 2 + 1] = b;
        ss += a * a + b * b;
      }
    }
    ss = wave_sum(ss);
    float r = rsqrtf(ss * (1.f / DM) + EPSF);
#pragma unroll
    for (int i = 0; i < 2; ++i) {
      int c = lane * 8 + 512 * i;
      float4 w0 = *(const float4*)(lw + c), w1 = *(const float4*)(lw + c + 4);
      float4 o0 = make_float4(x[i * 8 + 0] * r * w0.x, x[i * 8 + 1] * r * w0.y, x[i * 8 + 2] * r * w0.z, x[i * 8 + 3] * r * w0.w);
      float4 o1 = make_float4(x[i * 8 + 4] * r * w1.x, x[i * 8 + 5] * r * w1.y, x[i * 8 + 6] * r * w1.z, x[i * 8 + 7] * r * w1.w);
      *(float4*)(dst + c) = o0; *(float4*)(dst + c + 4) = o1;
    }
  }
}

__device__ void phase_mixnorm(const KP& p, int l) {
  int tid_ = threadIdx.x; asm volatile("" : "+v"(tid_));
  const int lane = tid_ & 63, w = tid_ >> 6;
  bfr* mix = (bfr*)(p.ws + OFF_MIX);
  const bfr* proj = (const bfr*)(p.ws + OFF_U);
  for (int row = p.bid * 8 + w; row < T_ROWS; row += p.nblk * 8) {
    bfr* mp = mix + (size_t)row * DM + lane * 16;
    u32x4 v0 = *(const u32x4*)mp, v1 = *(const u32x4*)(mp + 8);
    float x[16];
#pragma unroll
    for (int e = 0; e < 4; ++e) {
      x[e * 2] = __uint_as_float(v0[e] << 16); x[e * 2 + 1] = __uint_as_float(v0[e] & 0xffff0000u);
      x[8 + e * 2] = __uint_as_float(v1[e] << 16); x[8 + e * 2 + 1] = __uint_as_float(v1[e] & 0xffff0000u);
    }
    float ss = 0.f;
#pragma unroll
    for (int e = 0; e < 16; ++e) ss += x[e] * x[e];
    ss += __shfl_xor(ss, 1); ss += __shfl_xor(ss, 2); ss += __shfl_xor(ss, 4);
    float s8 = __shfl_xor(ss, 8);
    float r;
    if (lane < 32) r = rsqrtf((ss + s8) * (1.f / 256.f) + EPSF);
    else r = rsqrtf(ss * (1.f / 128.f) + EPSF);
    float o[16];
    if (lane < 32) {
      const float* nw = p.in[17] + l * 512 + lane * 16;
#pragma unroll
      for (int e = 0; e < 16; ++e) o[e] = x[e] * r * nw[e];
    } else {
      int cg0 = (lane - 32) * 16;
      const float* nw = p.in[19] + l * 512 + cg0;
      const bfr* gp = proj + (size_t)row * NIN + 3072 + cg0;
      u32x4 g0 = *(const u32x4*)gp, g1 = *(const u32x4*)(gp + 8);
      float g[16];
#pragma unroll
      for (int e = 0; e < 4; ++e) {
        g[e * 2] = __uint_as_float(g0[e] << 16); g[e * 2 + 1] = __uint_as_float(g0[e] & 0xffff0000u);
        g[8 + e * 2] = __uint_as_float(g1[e] << 16); g[8 + e * 2 + 1] = __uint_as_float(g1[e] & 0xffff0000u);
      }
#pragma unroll
      for (int e = 0; e < 16; ++e) o[e] = x[e] * r * nw[e] * siluf(g[e]);
    }
    u32x4 w0, w1;
#pragma unroll
    for (int e = 0; e < 4; ++e) { w0[e] = pack2(o[e * 2], o[e * 2 + 1]); w1[e] = pack2(o[8 + e * 2], o[8 + e * 2 + 1]); }
    *(u32x4*)mp = w0; *(u32x4*)(mp + 8) = w1;
  }
}

constexpr int BM = 256, BK = 64, HALF = 128, NXCD = 8, WGM = 8, HT = HALF * BK;

__device__ __forceinline__ int lds_byte(int r, int c) {
  int st = (r >> 4) * 2 + (c >> 5), rr = r & 15, cc = c & 31, ob = rr * 64 + cc * 2;
  return st * 1024 + (ob ^ (((ob >> 9) & 1) << 5));
}
__device__ __forceinline__ void stage_rc(int b, int& R, int& C) {
  int st = b / 1024, sb = b % 1024, swz = sb ^ (((sb >> 9) & 1) << 5);
  R = (st >> 1) * 16 + swz / 64; C = (st & 1) * 32 + (swz % 64) / 2;
}

template <int EPI, int N, int K>
__device__ __forceinline__ void gemm_phase(const KP& p, int l, const bfr* A, const bfr* Bt) {
  extern __shared__ __attribute__((aligned(16))) unsigned char smem[];
  bfr* shm = (bfr*)smem;
#define SA(b, h) (shm + ((b) * 2 + (h)) * HT)
#define SB(b, h) (shm + (4 + (b) * 2 + (h)) * HT)
#define STAGE_B(P, BASE, br, kt) do { const char* _gb = (const char*)((BASE) + (long)(br) * K + (long)(kt) * BK); \
    unsigned _o0 = so0, _o1 = so1; asm volatile("" : "+v"(_o0), "+v"(_o1)); \
    __builtin_amdgcn_global_load_lds((const unsigned*)(_gb + _o0), (unsigned*)((char*)(P) + tid * 16), 16, 0, 0); \
    __builtin_amdgcn_global_load_lds((const unsigned*)(_gb + _o1), (unsigned*)((char*)(P) + tid * 16 + 8192), 16, 0, 0); } while (0)
#define STAGE_A(P, BASE, br, kt) STAGE_B(P, BASE, br, kt)
#define LDA(dst, b, h) for (int m = 0; m < 4; ++m) for (int k = 0; k < 2; ++k) \
    dst[m][k] = *reinterpret_cast<const bf16x8*>((char*)SA(b, h) + lds_byte(wr * 64 + m * 16 + fr, k * 32 + fq * 8))
#define LDB(dst, b, h) for (int n = 0; n < 2; ++n) for (int k = 0; k < 2; ++k) \
    dst[n][k] = *reinterpret_cast<const bf16x8*>((char*)SB(b, h) + lds_byte(wc * 32 + n * 16 + fr, k * 32 + fq * 8))
#define MMA(ai, bj, At, Bq) do { __builtin_amdgcn_s_setprio(1); \
    for (int m = 0; m < 4; ++m) for (int n = 0; n < 2; ++n) for (int k = 0; k < 2; ++k) \
      acc[ai][bj][m][n] = __builtin_amdgcn_mfma_f32_16x16x32_bf16(Bq[n][k], At[m][k], acc[ai][bj][m][n], 0, 0, 0); \
    __builtin_amdgcn_s_setprio(0); } while (0)
#define WAIT_V(n) asm volatile("s_waitcnt vmcnt(" #n ")" ::: "memory")
#define WAIT_L(n) asm volatile("s_waitcnt lgkmcnt(" #n ")" ::: "memory")
#define BAR __builtin_amdgcn_s_barrier()
#define SCHED __builtin_amdgcn_sched_barrier(0)

  constexpr int TM = 256, HM = 128;
  const int nM = T_ROWS / TM, nN = N / BM, nwg = nM * nN;
  int tid = threadIdx.x; asm volatile("" : "+v"(tid));
  const int wid = tid >> 6, lane = tid & 63, wr = wid >> 2, wc = wid & 3, fr = lane & 15, fq = lane >> 4;
  const int nt = K / BK;
  unsigned so0, so1;
  { int _r, _c; stage_rc(tid * 16, _r, _c); so0 = (unsigned)(_r * K + _c) * 2u; stage_rc(tid * 16 + 8192, _r, _c); so1 = (unsigned)(_r * K + _c) * 2u; }
#define TILE_COORDS(LT, BROW, BCOL, PN) do { int wgid = (LT); \
    { int q = nwg / NXCD, r = nwg % NXCD, xcd = wgid % NXCD, off = wgid / NXCD; \
      wgid = (xcd < r ? xcd * (q + 1) : r * (q + 1) + (xcd - r) * q) + off; } \
    int nig = WGM * nN, gid = wgid / nig, fm = gid * WGM, gsz = min(nM - fm, WGM); \
    int pm_ = fm + ((wgid % nig) % gsz); PN = (wgid % nig) / gsz; BROW = pm_ * TM; BCOL = PN * BM; } while (0)
  int brow = 0, bcol = 0, pn = 0;
  if (p.bid < nwg) {
    TILE_COORDS(p.bid, brow, bcol, pn);
    STAGE_B(SB(0, 0), Bt, bcol, 0); STAGE_A(SA(0, 0), A, brow, 0);
    STAGE_B(SB(0, 1), Bt, bcol + HALF, 0); STAGE_A(SA(0, 1), A, brow + HM, 0);
  }
  for (int Lt = p.bid; Lt < nwg; Lt += p.nblk) {
    f32x4 acc[2][2][4][2];
#pragma unroll
    for (int a = 0; a < 2; ++a)
#pragma unroll
      for (int b = 0; b < 2; ++b)
#pragma unroll
        for (int m = 0; m < 4; ++m)
#pragma unroll
          for (int n = 0; n < 2; ++n) acc[a][b][m][n] = f32x4{0.f, 0.f, 0.f, 0.f};
    bf16x8 At[4][2], B0[2][2], B1[2][2];
    if (wr == 1) BAR;
    WAIT_V(4); BAR;
    STAGE_B(SB(1, 0), Bt, bcol, 1); STAGE_A(SA(1, 0), A, brow, 1); STAGE_B(SB(1, 1), Bt, bcol + HALF, 1);
    WAIT_V(6); BAR;
    for (int t = 0; t < nt - 2; t += 2) {
      LDB(B0, 0, 0); SCHED; LDA(At, 0, 0); STAGE_A(SA(1, 1), A, brow + HM, t + 1);
      WAIT_L(8); BAR; WAIT_L(0); MMA(0, 0, At, B0); BAR; SCHED;
      LDB(B1, 0, 1); STAGE_B(SB(0, 0), Bt, bcol, t + 2);
      BAR; WAIT_L(0); MMA(0, 1, At, B1); BAR;
      LDA(At, 0, 1); STAGE_A(SA(0, 0), A, brow, t + 2);
      BAR; WAIT_L(0); MMA(1, 0, At, B0); BAR; SCHED;
      STAGE_B(SB(0, 1), Bt, bcol + HALF, t + 2);
      WAIT_V(6); BAR; MMA(1, 1, At, B1); BAR;
      LDB(B0, 1, 0); SCHED; LDA(At, 1, 0); STAGE_A(SA(0, 1), A, brow + HM, t + 2);
      WAIT_L(8); BAR; WAIT_L(0); MMA(0, 0, At, B0); BAR; SCHED;
      LDB(B1, 1, 1); STAGE_B(SB(1, 0), Bt, bcol, t + 3);
      BAR; WAIT_L(0); MMA(0, 1, At, B1); BAR;
      LDA(At, 1, 1); STAGE_A(SA(1, 0), A, brow, t + 3);
      BAR; WAIT_L(0); MMA(1, 0, At, B0); BAR; SCHED;
      STAGE_B(SB(1, 1), Bt, bcol + HALF, t + 3);
      WAIT_V(6); BAR; MMA(1, 1, At, B1); BAR;
    }
    { LDB(B0, 0, 0); LDA(At, 0, 0); STAGE_A(SA(1, 1), A, brow + HM, nt - 1);
      BAR; WAIT_L(0); MMA(0, 0, At, B0); BAR;
      LDB(B1, 0, 1); BAR; WAIT_L(0); MMA(0, 1, At, B1); BAR;
      LDA(At, 0, 1); WAIT_V(4); BAR; WAIT_L(0); MMA(1, 0, At, B0); MMA(1, 1, At, B1); BAR; }
    { LDB(B0, 1, 0); LDA(At, 1, 0); WAIT_V(2); BAR; WAIT_L(0); MMA(0, 0, At, B0); BAR;
      LDB(B1, 1, 1); WAIT_V(0); BAR; WAIT_L(0); MMA(0, 1, At, B1); BAR;
      LDA(At, 1, 1); BAR; WAIT_L(0); MMA(1, 0, At, B0); MMA(1, 1, At, B1); BAR; }
    if (wr == 0) BAR;
    const int erow = brow, ecol = bcol, epn = pn;
    if (Lt + p.nblk < nwg) {
      TILE_COORDS(Lt + p.nblk, brow, bcol, pn);
      STAGE_B(SB(0, 0), Bt, bcol, 0); STAGE_A(SA(0, 0), A, brow, 0);
      STAGE_B(SB(0, 1), Bt, bcol + HALF, 0); STAGE_A(SA(0, 1), A, brow + HM, 0);
    }

    const float* rs = (const float*)(p.ws + OFF_RS);
    if (EPI == 1) {
      bfr* act = (bfr*)(p.ws + OFF_U);
#pragma unroll
      for (int ai = 0; ai < 2; ++ai)
#pragma unroll
        for (int m = 0; m < 4; ++m) {
          int row = erow + ai * HM + wr * 64 + m * 16 + fr;
          const float r = rs[row];
          const float nrl = -1.44269504f * r, r2 = r * r;
          u32x4 pk;
#pragma unroll
          for (int bj = 0; bj < 2; ++bj)
#pragma unroll
            for (int jj = 0; jj < 2; ++jj) {
              f32v2_t g2 = {acc[ai][bj][m][0][2 * jj], acc[ai][bj][m][0][2 * jj + 1]};
              f32v2_t u2 = {acc[ai][bj][m][1][2 * jj], acc[ai][bj][m][1][2 * jj + 1]};
              f32v2_t t2 = g2 * nrl;
              f32v2_t e2 = {__builtin_amdgcn_exp2f(t2.x), __builtin_amdgcn_exp2f(t2.y)};
              f32v2_t d2 = e2 + 1.0f;
              f32v2_t rc = {__builtin_amdgcn_rcpf(d2.x), __builtin_amdgcn_rcpf(d2.y)};
              f32v2_t o2 = (g2 * u2) * r2 * rc;
              pk[bj * 2 + jj] = pack2(o2.x, o2.y);
            }
          *(u32x4*)(act + (size_t)row * DFF + (ecol >> 1) + wc * 32 + fq * 8) = pk;
        }
    } else if (EPI == 2) {
      bfr* hb = (bfr*)(p.ws + OFF_HB);
#pragma unroll
      for (int ai = 0; ai < 2; ++ai)
#pragma unroll
        for (int m = 0; m < 4; ++m) {
          int row = erow + ai * HM + wr * 64 + m * 16 + fr;
#pragma unroll
          for (int bj = 0; bj < 2; ++bj) {
            u32x4* hp = (u32x4*)(hb + (size_t)row * DM + ecol + bj * HALF + wc * 32 + fq * 8);
            u32x4 h = *hp, o;
#pragma unroll
            for (int q2 = 0; q2 < 4; ++q2) {
              f32v2_t hv2 = {__uint_as_float(h[q2] << 16), __uint_as_float(h[q2] & 0xffff0000u)};
              f32v2_t av2 = {acc[ai][bj][m][q2 >> 1][(q2 & 1) * 2], acc[ai][bj][m][q2 >> 1][(q2 & 1) * 2 + 1]};
              f32v2_t s2 = hv2 + av2;
              o[q2] = pack2(s2.x, s2.y);
            }
            *hp = o;
          }
        }
    } else {
      bfr* proj = (bfr*)(p.ws + OFF_U);
      float* dtb = (float*)(p.ws + OFF_DT);
#pragma unroll
      for (int ai = 0; ai < 2; ++ai)
#pragma unroll
        for (int m = 0; m < 4; ++m) {
          int row = erow + ai * HM + wr * 64 + m * 16 + fr;
          float r = rs[row];
          if (epn < 14) {
            float* cdst = nullptr;
            bfr* tdst = nullptr;
            if (ecol >= 512 && ecol < 1536) {
              { int cid, tl;
                if (row < SROW0) { int s = row / PROW, pos = row % PROW; cid = s * 65 + (pos >> 6); tl = (pos & 63) - 61; }
                else { int rr = row - SROW0; cid = 520 + (rr >> 6); tl = (rr & 63) - 61; }
                if (tl >= 0) tdst = (bfr*)(p.ws + OFF_TAILS) + ((size_t)cid * 3 + tl) * 1024; }
              if (row < SROW0) { int s = row / PROW, tl = row % PROW - (PLEN - 3); if (tl >= 0 && tl < 3) cdst = p.out + O_CP + ((size_t)(l * 8 + s) * 3 + tl) * 1024; }
              else { int s = (row - SROW0) >> 6, tl = ((row - SROW0) & 63) - 61; if (tl >= 0) cdst = p.out + O_CS + ((size_t)(l * 8 + s) * 3 + tl) * 1024; }
            }
#pragma unroll
            for (int bj = 0; bj < 2; ++bj) {
              int col = ecol + bj * HALF + wc * 32 + fq * 8;
              float v[8];
#pragma unroll
              for (int n = 0; n < 2; ++n)
#pragma unroll
                for (int jj = 0; jj < 2; ++jj) {
                  f32v2_t t2 = f32v2_t{acc[ai][bj][m][n][2 * jj], acc[ai][bj][m][n][2 * jj + 1]} * r;
                  v[n * 4 + 2 * jj] = t2.x; v[n * 4 + 2 * jj + 1] = t2.y;
                }
              u32x4 pk; pk[0] = pack2(v[0], v[1]); pk[1] = pack2(v[2], v[3]); pk[2] = pack2(v[4], v[5]); pk[3] = pack2(v[6], v[7]);
              *(u32x4*)(proj + (size_t)row * NIN + col) = pk;
              if (cdst) { *(float4*)(cdst + col - 512) = make_float4(v[0], v[1], v[2], v[3]); *(float4*)(cdst + col - 512 + 4) = make_float4(v[4], v[5], v[6], v[7]); }
              if (tdst) *(u32x4*)(tdst + col - 512) = pk;
            }
          } else {
            if (wc == 0 && fq == 0) {
              *(float4*)(dtb + (size_t)row * 8) = make_float4(acc[ai][0][m][0][0] * r, acc[ai][0][m][0][1] * r, acc[ai][0][m][0][2] * r, acc[ai][0][m][0][3] * r);
              *(float4*)(dtb + (size_t)row * 8 + 4) = make_float4(acc[ai][0][m][1][0] * r, acc[ai][0][m][1][1] * r, acc[ai][0][m][1][2] * r, acc[ai][0][m][1][3] * r);
            }
          }
        }
    }
  }
#undef SA
#undef TILE_COORDS
#undef SB
#undef STAGE_A
#undef STAGE_B
#undef LDA
#undef LDB
#undef MMA
}

__device__ __forceinline__ f32x4 mma_lds(const bfr* A, int lda, const bfr* B, int ldb, int ksteps, f32x4 acc, int fr, int fq) {
  for (int ks = 0; ks < ksteps; ++ks) {
    bf16x8 a = *(const bf16x8*)(A + fr * lda + ks * 32 + fq * 8);
    bf16x8 b = *(const bf16x8*)(B + fr * ldb + ks * 32 + fq * 8);
    acc = __builtin_amdgcn_mfma_f32_16x16x32_bf16(a, b, acc, 0, 0, 0);
  }
  return acc;
}

__device__ __forceinline__ f32x4 mma_gl(const bf16x8* af, const bfr* B, int ldb, int ksteps, f32x4 acc, int fr, int fq) {
  bf16x8 b0 = *(const bf16x8*)(B + fr * ldb + 0 * 32 + fq * 8);
  bf16x8 b1 = *(const bf16x8*)(B + fr * ldb + 1 * 32 + fq * 8);
  bf16x8 b2 = *(const bf16x8*)(B + fr * ldb + 2 * 32 + fq * 8);
  bf16x8 b3 = *(const bf16x8*)(B + fr * ldb + 3 * 32 + fq * 8);
  f32x4 c0 = acc, c1 = f32x4{0.f, 0.f, 0.f, 0.f};
  c0 = __builtin_amdgcn_mfma_f32_16x16x32_bf16(af[0], b0, c0, 0, 0, 0);
  c1 = __builtin_amdgcn_mfma_f32_16x16x32_bf16(af[1], b1, c1, 0, 0, 0);
  c0 = __builtin_amdgcn_mfma_f32_16x16x32_bf16(af[2], b2, c0, 0, 0, 0);
  c1 = __builtin_amdgcn_mfma_f32_16x16x32_bf16(af[3], b3, c1, 0, 0, 0);
  (void)ksteps;
  return c0 + c1;
}

__device__ void ssd_pre(const KP& p, int l, int cid, int g) {
  extern __shared__ __attribute__((aligned(16))) unsigned char smem[];
  int tid_ = threadIdx.x; asm volatile("" : "+v"(tid_));
  const int tid = tid_, w = tid >> 6, lane = tid & 63, fr = lane & 15, fq = lane >> 4;
  bfr* Cs = (bfr*)smem;
  bfr* Bs = Cs + 64 * 136;
  bfr* BTs = Bs + 64 * 136;
  bfr* xTs = BTs + 128 * 72;
  bfr* Gs = xTs + 256 * 72;
  float* dtv = (float*)(Gs + 64 * 72);
  float* cumv = dtv + 256;
  float* ev = cumv + 256;

  bool prompt, first; int r0, pos0, len, sb = 0;
  if (cid < 520) { int s = cid / 65, c = cid % 65; prompt = true; first = (c == 0); r0 = s * PROW + c * 64; pos0 = c * 64; len = PLEN; }
  else { sb = cid - 520; prompt = false; first = true; r0 = SROW0 + sb * 64; pos0 = 0; len = 64; }
  bfr* proj = (bfr*)(p.ws + OFF_U);
  float* dtbuf = (float*)(p.ws + OFF_DT);
  bfr* mix = (bfr*)(p.ws + OFF_MIX);
  const bfr* tails = (const bfr*)(p.ws + OFF_TAILS);
  const float* convw = p.in[12] + (size_t)l * 4 * 1024;
  const float* convb = p.in[13] + (size_t)l * 1024;

  if (tid < 256) {
    int hh = tid >> 6, i = tid & 63, h = g * 4 + hh;
    float x = dtbuf[(size_t)(r0 + i) * 8 + h] + p.in[14][l * 8 + h];
    float dt = (x > 20.f) ? x : __logf(1.f + __expf(x));
    if (pos0 + i >= len) dt = 0.f;
    float cum = dt * (-__expf(p.in[15][l * 8 + h]));
#pragma unroll
    for (int o = 1; o < 64; o <<= 1) { float t = __shfl_up(cum, o); if (i >= o) cum += t; }
    float cl = __shfl(cum, 63);
    dtv[tid] = dt; cumv[tid] = cum; ev[tid] = dt * __expf(cl - cum);
    dtbuf[(size_t)(r0 + i) * 8 + h] = cum;
  }
  {
    const int item = tid;
    const int pair = item & 255, half_ = item >> 8, cc0 = pair * 2;
    const int rs_ = half_ * 32, re_ = rs_ + 32;
    const int ch = (cc0 < 256) ? (g * 256 + cc0) : ((cc0 < 384) ? (512 + g * 128 + cc0 - 256) : (768 + g * 128 + cc0 - 384));
    float w0[5], w1[5];
#pragma unroll
    for (int k = 0; k < 4; ++k) { w0[k] = convw[k * 1024 + ch]; w1[k] = convw[k * 1024 + ch + 1]; }
    w0[4] = convb[ch]; w1[4] = convb[ch + 1];
    float a0[3], a1[3];
#pragma unroll
    for (int k = 0; k < 3; ++k) {
      int rr = rs_ - 3 + k;
      float x0 = 0.f, x1 = 0.f;
      if (rr >= 0) { unsigned u = *(const unsigned*)(proj + (size_t)(r0 + rr) * NIN + 512 + ch); x0 = __uint_as_float(u << 16); x1 = __uint_as_float(u & 0xffff0000u); }
      else if (!first) { unsigned u = *(const unsigned*)(tails + ((size_t)(cid - 1) * 3 + (rr + 3)) * 1024 + ch); x0 = __uint_as_float(u << 16); x1 = __uint_as_float(u & 0xffff0000u); }
      else if (!prompt) { const float* sp = p.in[2] + (((size_t)l * 8 + sb) * 3 + (rr + 3)) * 1024 + ch; x0 = bf2f(f2bf(sp[0])); x1 = bf2f(f2bf(sp[1])); }
      a0[k] = x0; a1[k] = x1;
    }
    f32v2_t wv[5], av[3];
#pragma unroll
    for (int k = 0; k < 5; ++k) wv[k] = f32v2_t{w0[k], w1[k]};
#pragma unroll
    for (int k = 0; k < 3; ++k) av[k] = f32v2_t{a0[k], a1[k]};
    const bfr* gp = proj + (size_t)r0 * NIN + 512 + ch;
    int nin_ = NIN; asm volatile("" : "+s"(nin_));
    unsigned ur[32];
#pragma unroll
    for (int k = 0; k < 32; ++k) { int i = rs_ + k; ur[k] = *(const unsigned*)(gp + (size_t)i * nin_); }
#pragma unroll
    for (int k = 0; k < 32; ++k) {
      const int i = rs_ + k;
      if (i < re_) {
        unsigned u = ur[k];
        float x0 = __uint_as_float(u << 16), x1 = __uint_as_float(u & 0xffff0000u);
        f32v2_t xv = {x0, x1};
        f32v2_t vv = wv[4] + av[0] * wv[0] + av[1] * wv[1] + av[2] * wv[2] + xv * wv[3];
        av[0] = av[1]; av[1] = av[2]; av[2] = xv;
        f32v2_t tv = vv * -1.44269504f;
        f32v2_t ev = {__builtin_amdgcn_exp2f(tv.x), __builtin_amdgcn_exp2f(tv.y)};
        f32v2_t dv = ev + 1.0f;
        f32v2_t rv = {__builtin_amdgcn_rcpf(dv.x), __builtin_amdgcn_rcpf(dv.y)};
        vv = vv * rv;
        float v0 = vv.x, v1 = vv.y;
        if (cc0 < 256) { xTs[cc0 * 72 + i] = f2bf(v0); xTs[(cc0 + 1) * 72 + i] = f2bf(v1); }
        else if (cc0 < 384) {
          int n = cc0 - 256; unsigned pk = pack2(v0, v1);
          *(unsigned*)(Bs + i * 136 + n) = pk;
          BTs[n * 72 + i] = (bfr)(pk & 0xffffu); BTs[(n + 1) * 72 + i] = (bfr)(pk >> 16);
        } else *(unsigned*)(Cs + i * 136 + (cc0 - 384)) = pack2(v0, v1);
      }
    }
  }
  __syncthreads();
  f32x4 cb[2];
#pragma unroll
  for (int q = 0; q < 2; ++q) {
    int t = w * 2 + q, ti = t >> 2, tj = t & 3;
    cb[q] = f32x4{0.f, 0.f, 0.f, 0.f};
    if (tj <= ti) cb[q] = mma_lds(Cs + ti * 16 * 136, 136, Bs + tj * 16 * 136, 136, 4, cb[q], fr, fq);
  }
#pragma unroll
  for (int it = 0; it < 2; ++it) {
    int e = tid + 512 * it;
    { int i = e >> 4, sg = e & 15; *(u32x4*)(proj + (size_t)(r0 + i) * NIN + 1280 + g * 128 + sg * 8) = *(const u32x4*)(Cs + i * 136 + sg * 8); }
    { int n = e >> 3, sg = e & 7; *(u32x4*)(proj + (size_t)(r0 + (n >> 1)) * NIN + 1024 + g * 128 + (n & 1) * 64 + sg * 8) = *(const u32x4*)(BTs + n * 72 + sg * 8); }
  }
#pragma unroll
  for (int it = 0; it < 4; ++it) {
    int e = tid + 512 * it, xr = e >> 3, sg = e & 7, hh = xr >> 6, pp = xr & 63;
    u32x4 v = *(const u32x4*)(xTs + xr * 72 + sg * 8), o;
#pragma unroll
    for (int k = 0; k < 4; ++k) {
      float e0 = ev[hh * 64 + sg * 8 + 2 * k], e1 = ev[hh * 64 + sg * 8 + 2 * k + 1];
      o[k] = pack2(__uint_as_float(v[k] << 16) * e0, __uint_as_float(v[k] & 0xffff0000u) * e1);
    }
    *(u32x4*)(proj + (size_t)(r0 + pp) * NIN + 512 + (g * 4 + hh) * 64 + sg * 8) = o;
  }
  for (int hh = 0; hh < 4; ++hh) {
    const int h = g * 4 + hh;
    const float Dh = p.in[16][l * 8 + h];
#pragma unroll
    for (int q = 0; q < 2; ++q) {
      int t = w * 2 + q, ti = t >> 2, tj = t & 3, jx = tj * 16 + fr;
      float cj = cumv[hh * 64 + jx], dj = dtv[hh * 64 + jx];
#pragma unroll
      for (int j = 0; j < 4; ++j) {
        int i = ti * 16 + fq * 4 + j;
        float gv = (tj <= ti && jx <= i) ? cb[q][j] * __expf(cumv[hh * 64 + i] - cj) * dj : 0.f;
        Gs[i * 72 + jx] = f2bf(gv);
      }
    }
    __syncthreads();
#pragma unroll
    for (int q = 0; q < 2; ++q) {
      int t = w * 2 + q, ti = t >> 2, tp = t & 3;
      f32x4 a = f32x4{0.f, 0.f, 0.f, 0.f};
      a = mma_lds(Gs + ti * 16 * 72, 72, xTs + (hh * 64 + tp * 16) * 72, 72, 2, a, fr, fq);
      int pp = tp * 16 + fr;
#pragma unroll
      for (int j = 0; j < 4; ++j) {
        int i = ti * 16 + fq * 4 + j;
        float y = a[j] + Dh * bf2f(xTs[(hh * 64 + pp) * 72 + i]);
        mix[(size_t)(r0 + i) * DM + h * 64 + pp] = f2bf(y);
      }
    }
    __syncthreads();
  }
}

__device__ __forceinline__ void store_bf16_asm(bfr* addr, unsigned v) { asm volatile("global_store_short %0, %1, off" :: "v"(addr), "v"(v) : "memory"); }

__device__ void ssd_seq(const KP& p, int l, int s, int h, int ph) {
  extern __shared__ __attribute__((aligned(16))) unsigned char smem[];
  int tid_ = threadIdx.x; asm volatile("" : "+v"(tid_));
  const int tid = tid_, w = tid >> 6, lane = tid & 63, fr = lane & 15, fq = lane >> 4;
  bfr* Sbs = (bfr*)smem;
  const bool prompt = s < 8;
  const int sb = s & 7;
  const int row0 = prompt ? s * PROW : SROW0 + sb * 64;
  const int nch = prompt ? 65 : 1, len = prompt ? PLEN : 64;
  const int g = h >> 2;
  const bfr* proj = (const bfr*)(p.ws + OFF_U);
  const float* cumb = (const float*)(p.ws + OFF_DT);
  bfr* mix = (bfr*)(p.ws + OFF_MIX);
  const int ti = w >> 1, tp = w & 1;
  const int zc = h * 64 + ph * 32 + tp * 16 + fr;

  f32x4 Sacc[2];
#pragma unroll
  for (int pt = 0; pt < 2; ++pt)
#pragma unroll
    for (int j = 0; j < 4; ++j) {
      int pp = pt * 16 + fq * 4 + j, n = 16 * w + fr;
      float v = 0.f;
      if (!prompt) v = p.in[3][((((size_t)l * 8 + sb) * 8 + h) * 64 + ph * 32 + pp) * 128 + n];
      Sacc[pt][j] = v;
      Sbs[pp * 136 + n] = f2bf(v);
    }
  __syncthreads();

  bf16x8 Cs_[2][4], Xs_[2][2][2], Bs_[2][2];
  bfr ys_[2][4], zs_[2][4]; float cus_[2][4], cls_[2];
  const int nB = 16 * w + fr;
#define LBAR() do { asm volatile("s_waitcnt lgkmcnt(0)" ::: "memory"); __builtin_amdgcn_s_barrier(); asm volatile("" ::: "memory"); } while (0)
  const unsigned coff = (unsigned)(((ti * 16 + fr) * NIN + 1280 + g * 128 + fq * 8) * 2);
  unsigned xoff[2];
#pragma unroll
  for (int pt = 0; pt < 2; ++pt) xoff[pt] = (unsigned)(((ph * 32 + pt * 16 + fr) * NIN + 512 + h * 64 + fq * 8) * 2);
  const unsigned boff = (unsigned)((((nB >> 1)) * NIN + 1024 + g * 128 + (nB & 1) * 64 + fq * 8) * 2);
  const unsigned zoff = (unsigned)(((ti * 16 + fq * 4) * NIN + zc) * 2);
  const unsigned yoff = (unsigned)(((ti * 16 + fq * 4) * DM + zc) * 2);
  const unsigned cuoff = (unsigned)(((ti * 16 + fq * 4) * 8 + h) * 4);
#define SSD_LOAD(SET, R0) do { const int _r0 = (R0); \
    const char* _pb = (const char*)proj + (size_t)_r0 * (NIN * 2); \
    const char* _mb = (const char*)mix + (size_t)_r0 * (DM * 2); \
    const char* _cb = (const char*)cumb + (size_t)_r0 * 32; \
    for (int ks = 0; ks < 4; ++ks) Cs_[SET][ks] = *(const bf16x8*)(_pb + coff + ks * 64); \
    for (int pt = 0; pt < 2; ++pt) for (int ks = 0; ks < 2; ++ks) Xs_[SET][pt][ks] = *(const bf16x8*)(_pb + xoff[pt] + ks * 64); \
    for (int ks = 0; ks < 2; ++ks) Bs_[SET][ks] = *(const bf16x8*)(_pb + boff + ks * 64); \
    for (int j = 0; j < 4; ++j) { ys_[SET][j] = *(const bfr*)(_mb + yoff + j * (DM * 2)); zs_[SET][j] = *(const bfr*)(_pb + zoff + j * (NIN * 2)); cus_[SET][j] = *(const float*)(_cb + cuoff + j * 32); } \
    cls_[SET] = *(const float*)(_cb + (63 * 8 + h) * 4); } while (0)
#define SSD_STEP(k, c) do { const int r0 = row0 + (c) * 64; \
    { f32x4 a2 = f32x4{0.f, 0.f, 0.f, 0.f}; \
      a2 = mma_gl(Cs_[k], Sbs + ((k) & 1) * (32 * 136) + tp * 16 * 136, 136, 4, a2, fr, fq); \
      for (int j = 0; j < 4; ++j) { \
        int i = ti * 16 + fq * 4 + j; \
        float y = bf2f(ys_[k][j]) + __expf(cus_[k][j]) * a2[j]; \
        float yz = y * siluf(bf2f(zs_[k][j])); \
        if ((c) * 64 + i >= len) yz = 0.f; \
        store_bf16_asm((bfr*)((char*)mix + (size_t)r0 * (DM * 2) + yoff + j * (DM * 2)), (unsigned)f2bf(yz)); \
      } } \
    { float dec = __expf(cls_[k]); \
      for (int pt = 0; pt < 2; ++pt) { \
        f32x4 a = Sacc[pt]; \
        a[0] *= dec; a[1] *= dec; a[2] *= dec; a[3] *= dec; \
        for (int ks = 0; ks < 2; ++ks) a = __builtin_amdgcn_mfma_f32_16x16x32_bf16(Xs_[k][pt][ks], Bs_[k][ks], a, 0, 0, 0); \
        Sacc[pt] = a; \
        for (int j = 0; j < 4; ++j) Sbs[(((k) + 1) & 1) * (32 * 136) + (pt * 16 + fq * 4 + j) * 136 + 16 * w + fr] = f2bf(a[j]); \
      } } } while (0)
#pragma unroll
  for (int k = 0; k < 2; ++k) SSD_LOAD(k, row0 + min(k, nch - 1) * 64);
  int c0 = 0;
  for (; c0 + 1 < nch; c0 += 2) {
#pragma unroll
    for (int k = 0; k < 2; ++k) {
      const int c = c0 + k;
      SSD_STEP(k, c);
      SSD_LOAD(k, row0 + min(c + 2, nch - 1) * 64);
      LBAR();
    }
  }
  if (c0 < nch) { SSD_STEP(0, c0); LBAR(); }
#undef SSD_STEP
#undef LBAR
#undef SSD_LOAD
  float* so = p.out + (prompt ? O_SP : O_SS) + (((size_t)l * 8 + sb) * 8 + h) * 64 * 128;
#pragma unroll
  for (int pt = 0; pt < 2; ++pt)
#pragma unroll
    for (int j = 0; j < 4; ++j) so[(size_t)(ph * 32 + pt * 16 + fq * 4 + j) * 128 + 16 * w + fr] = Sacc[pt][j];
}

__device__ __forceinline__ void gla_pre(const KP& p, int l, int sbid, int h, bfr (&qn)[8], bfr (&fn)[8], u32x4& vv, bool have, bool want_next) {
  extern __shared__ __attribute__((aligned(16))) unsigned char smem[];
  int tid_ = threadIdx.x; asm volatile("" : "+v"(tid_));
  const int tid = tid_, w = tid >> 6, lane = tid & 63, fr = lane & 15, fq = lane >> 4;
  bfr* qes = (bfr*)smem;
  bfr* kes = qes + 32 * 136;
  bfr* kdTs = kes + 32 * 136;
  bfr* vTs = kdTs + 128 * 40;
  bfr* atts = vTs + 128 * 40;
  float* segs = (float*)(atts + 32 * 40);

  int r0, pos0, len;
  if (sbid < 1040) { int s = sbid / 130, st = sbid % 130; r0 = s * PROW + st * 32; pos0 = st * 32; len = PLEN; }
  else { int x = sbid - 1040; r0 = SROW0 + x * 32; pos0 = (x & 1) * 32; len = 64; }
  bfr* proj = (bfr*)(p.ws + OFF_U);
  bfr* mix = (bfr*)(p.ws + OFF_MIX);
  float* decb = (float*)(p.ws + OFF_DEC);
  const int kk_ = tid & 127, seg = tid >> 7;
  float lb = 0.f;
  if (l == 1) {
    float d = p.in[18][512 + h * 128 + kk_] - p.in[18][h * 128 + kk_];
    lb = fminf(__builtin_amdgcn_rcpf(1.f + __expf(-d)), 1.f - 1e-6f);
  }
  float qv[8], kv[8], cm[8];
#define GLAPRE_LOAD(H) do { \
    for (int it = 0; it < 8; ++it) { size_t rb = (size_t)(r0 + seg * 8 + it) * NIN; \
      qn[it] = proj[rb + 1536 + (H) * 128 + kk_]; fn[it] = proj[rb + 2048 + (H) * 128 + kk_]; } \
    { int j = tid >> 4, sg = tid & 15; vv = *(const u32x4*)(proj + (size_t)(r0 + j) * NIN + 2560 + (H) * 128 + sg * 8); } } while (0)
  if (!have) GLAPRE_LOAD(h);
  {
    float run = 0.f;
#pragma unroll
    for (int it = 0; it < 8; ++it) {
      int j = seg * 8 + it;
      float hq = bf2f(qn[it]), fx = bf2f(fn[it]);
      qv[it] = siluf(hq);
      float ex_ = __expf(fx);
      float sg_ = __builtin_amdgcn_rcpf(1.f + ex_);
      float kkv = (1.f - lb) * sg_;
      float fsel = (kkv < 0.5f) ? (1.f - kkv) : fmaxf(lb + (1.f - lb) * ex_ * sg_, 1e-30f);
      float lf = __logf(fsel);
      if (pos0 + j >= len) { kkv = 0.f; lf = 0.f; }
      kv[it] = kkv;
      run += lf; cm[it] = run;
    }
    segs[seg * 128 + kk_] = run;
    { int j = tid >> 4, sg = tid & 15;
#pragma unroll
      for (int k = 0; k < 4; ++k) { vTs[(sg * 8 + 2 * k) * 40 + j] = (bfr)(vv[k] & 0xffffu); vTs[(sg * 8 + 2 * k + 1) * 40 + j] = (bfr)(vv[k] >> 16); } }
  }
  __syncthreads();
  if (want_next) GLAPRE_LOAD(h + 1);
#undef GLAPRE_LOAD
  {
    float s0 = segs[kk_], s1 = segs[128 + kk_], s2 = segs[256 + kk_], s3 = segs[384 + kk_];
    float base = (seg > 0 ? s0 : 0.f) + (seg > 1 ? s1 : 0.f) + (seg > 2 ? s2 : 0.f);
    float cl = s0 + s1 + s2 + s3;
    const float ecl = __expf(cl);
    if (seg == 0) decb[((size_t)sbid * 4 + h) * 128 + kk_] = ecl;
#pragma unroll
    for (int it = 0; it < 8; ++it) {
      int j = seg * 8 + it;
      float c = base + cm[it];
      float en = __expf(-c), kn = kv[it] * en;
      qes[j * 136 + kk_] = f2bf(qv[it] * __expf(c));
      kes[j * 136 + kk_] = f2bf(kn);
      kdTs[kk_ * 40 + j] = f2bf(kn * ecl);
    }
  }
  asm volatile("s_waitcnt lgkmcnt(0)" ::: "memory"); __builtin_amdgcn_s_barrier(); asm volatile("" ::: "memory");
  if (w < 4) {
    int ti = w >> 1, tj = w & 1;
    f32x4 a = f32x4{0.f, 0.f, 0.f, 0.f};
    if (tj <= ti) a = mma_lds(qes + ti * 16 * 136, 136, kes + tj * 16 * 136, 136, 4, a, fr, fq);
    int jx = tj * 16 + fr;
#pragma unroll
    for (int j = 0; j < 4; ++j) {
      int i = ti * 16 + fq * 4 + j;
      atts[i * 40 + jx] = f2bf((tj <= ti && jx <= i) ? a[j] : 0.f);
    }
  }
  { int j = tid >> 4, sg = tid & 15; *(u32x4*)(proj + (size_t)(r0 + j) * NIN + 1536 + h * 128 + sg * 8) = *(const u32x4*)(qes + j * 136 + sg * 8); }
  { int k = tid >> 2, sg = tid & 3;
    *(u32x4*)(proj + (size_t)(r0 + (k >> 2)) * NIN + 2048 + h * 128 + (k & 3) * 32 + sg * 8) = *(const u32x4*)(kdTs + k * 40 + sg * 8);
    *(u32x4*)(proj + (size_t)(r0 + (k >> 2)) * NIN + 2560 + h * 128 + (k & 3) * 32 + sg * 8) = *(const u32x4*)(vTs + k * 40 + sg * 8); }
  asm volatile("s_waitcnt lgkmcnt(0)" ::: "memory"); __builtin_amdgcn_s_barrier(); asm volatile("" ::: "memory");
#pragma unroll
  for (int q = 0; q < 2; ++q) {
    int t = w * 2 + q, ti = t >> 3, tv = t & 7;
    f32x4 a = f32x4{0.f, 0.f, 0.f, 0.f};
    a = mma_lds(atts + ti * 16 * 40, 40, vTs + tv * 16 * 40, 40, 1, a, fr, fq);
#pragma unroll
    for (int j = 0; j < 4; ++j) {
      int i = ti * 16 + fq * 4 + j;
      mix[(size_t)(r0 + i) * DM + 512 + h * 128 + tv * 16 + fr] = f2bf(a[j]);
    }
  }
  asm volatile("s_waitcnt lgkmcnt(0)" ::: "memory"); __builtin_amdgcn_s_barrier(); asm volatile("" ::: "memory");
}

__device__ void gla_seq(const KP& p, int l, int s, int h, int vq) {
  extern __shared__ __attribute__((aligned(16))) unsigned char smem[];
  int tid_ = threadIdx.x; asm volatile("" : "+v"(tid_));
  const int tid = tid_, w = tid >> 6, lane = tid & 63, fr = lane & 15, fq = lane >> 4;
  bfr* STs = (bfr*)smem;
  const bool prompt = s < 8;
  const int sb = s & 7;
  const int row0 = prompt ? s * PROW : SROW0 + sb * 64;
  const int nst = prompt ? 130 : 2, len = prompt ? PLEN : 64;
  const int sbid0 = prompt ? s * 130 : 1040 + sb * 2;
  const bfr* proj = (const bfr*)(p.ws + OFF_U);
  const float* decb = (const float*)(p.ws + OFF_DEC);
  bfr* mix = (bfr*)(p.ws + OFF_MIX);
  const int ti = (w >> 1) & 1, tv = w & 1;
  const int oc = 512 + h * 128 + vq * 32 + tv * 16 + fr;

  f32x4 Sacc[2];
#pragma unroll
  for (int vt = 0; vt < 2; ++vt)
#pragma unroll
    for (int j = 0; j < 4; ++j) {
      int k = 16 * w + fq * 4 + j, v = vt * 16 + fr;
      float x = 0.f;
      if (!prompt) x = p.in[4][((((size_t)l * 8 + sb) * 4 + h) * 128 + k) * 128 + vq * 32 + v];
      Sacc[vt][j] = x;
      STs[v * 136 + k] = f2bf(x);
    }
  __syncthreads();

  bf16x8 Qs[4][4], Ks[4], Vs[4][2];
  bfr os_[4][4]; float ds_[4][4];
  const int kA = 16 * w + fr;
#define LBAR() do { asm volatile("s_waitcnt lgkmcnt(0)" ::: "memory"); __builtin_amdgcn_s_barrier(); asm volatile("" ::: "memory"); } while (0)
  const unsigned qoff = (unsigned)(((ti * 16 + fr) * NIN + 1536 + h * 128 + fq * 8) * 2);
  const unsigned koff = (unsigned)((((kA >> 2)) * NIN + 2048 + h * 128 + (kA & 3) * 32 + fq * 8) * 2);
  unsigned voff[2];
#pragma unroll
  for (int vt = 0; vt < 2; ++vt) { int _v = vq * 32 + vt * 16 + fr; voff[vt] = (unsigned)(((_v >> 2) * NIN + 2560 + h * 128 + (_v & 3) * 32 + fq * 8) * 2); }
  const unsigned ooff = (unsigned)(((ti * 16 + fq * 4) * DM + oc) * 2);
  const unsigned doff = (unsigned)((h * 128 + 16 * w + fq * 4) * 4);
#define GLA_LOAD(SET, ST) do { const int _st = (ST); \
    const char* _pb = (const char*)proj + (size_t)(row0 + _st * 32) * (NIN * 2); \
    const char* _mb = (const char*)mix + (size_t)(row0 + _st * 32) * (DM * 2); \
    const char* _db = (const char*)decb + (size_t)(sbid0 + _st) * (4 * 128 * 4); \
    for (int ks = 0; ks < 4; ++ks) Qs[SET][ks] = *(const bf16x8*)(_pb + qoff + ks * 64); \
    for (int j = 0; j < 4; ++j) os_[SET][j] = *(const bfr*)(_mb + ooff + j * (DM * 2)); \
    Ks[SET] = *(const bf16x8*)(_pb + koff); \
    for (int vt = 0; vt < 2; ++vt) Vs[SET][vt] = *(const bf16x8*)(_pb + voff[vt]); \
    { const f32x4 _d = *(const f32x4*)(_db + doff); ds_[SET][0] = _d[0]; ds_[SET][1] = _d[1]; ds_[SET][2] = _d[2]; ds_[SET][3] = _d[3]; } } while (0)
#define GLA_STEP(k, st) do { const int r0 = row0 + (st) * 32; \
    if (w < 4) { \
      f32x4 a = f32x4{0.f, 0.f, 0.f, 0.f}; \
      a = mma_gl(Qs[k], STs + ((k) & 1) * (32 * 136) + tv * 16 * 136, 136, 4, a, fr, fq); \
      for (int j = 0; j < 4; ++j) { \
        int i = ti * 16 + fq * 4 + j; \
        float o = bf2f(os_[k][j]) + a[j]; \
        if ((st) * 32 + i >= len) o = 0.f; \
        store_bf16_asm((bfr*)((char*)mix + (size_t)r0 * (DM * 2) + ooff + j * (DM * 2)), (unsigned)f2bf(o)); \
      } \
    } \
    for (int vt = 0; vt < 2; ++vt) { \
      f32x4 a = Sacc[vt]; \
      for (int j = 0; j < 4; ++j) a[j] *= ds_[k][j]; \
      a = __builtin_amdgcn_mfma_f32_16x16x32_bf16(Ks[k], Vs[k][vt], a, 0, 0, 0); \
      Sacc[vt] = a; \
      for (int j = 0; j < 4; ++j) STs[(((k) + 1) & 1) * (32 * 136) + (vt * 16 + fr) * 136 + 16 * w + fq * 4 + j] = f2bf(a[j]); \
    } } while (0)
#pragma unroll
  for (int k = 0; k < 4; ++k) GLA_LOAD(k, min(k, nst - 1));
  int st0 = 0;
  for (; st0 + 3 < nst; st0 += 4) {
#pragma unroll
    for (int k = 0; k < 4; ++k) {
      const int st = st0 + k;
      GLA_STEP(k, st);
      GLA_LOAD(k, min(st + 4, nst - 1));
      LBAR();
    }
  }
#pragma unroll
  for (int k = 0; k < 4; ++k) {
    const int st = st0 + k;
    if (st < nst) { GLA_STEP(k, st); LBAR(); }
  }
#undef GLA_STEP
#undef LBAR
#undef GLA_LOAD
  float* so = p.out + (prompt ? O_HP : O_HS) + (((size_t)l * 8 + sb) * 4 + h) * 128 * 128;
#pragma unroll
  for (int vt = 0; vt < 2; ++vt)
#pragma unroll
    for (int j = 0; j < 4; ++j) so[(size_t)(16 * w + fq * 4 + j) * 128 + vq * 32 + vt * 16 + fr] = Sacc[vt][j];
}

__device__ void phase_pre(const KP& p, int l) {
  for (int u = p.bid; u < 1056; u += p.nblk) ssd_pre(p, l, u >> 1, u & 1);
  int lo, hi;
  if (p.nblk == 256) { if (p.bid < 32) { lo = p.bid * 13; hi = lo + 13; } else { lo = 416 + (p.bid - 32) * 17; hi = lo + 17; } }
  else { lo = (int)((long)4224 * p.bid / p.nblk); hi = (int)((long)4224 * (p.bid + 1) / p.nblk); }
  bfr qn[8], fn[8]; u32x4 vv;
  for (int v = lo; v < hi; ++v) {
    const bool have = (v > lo) && ((v & 3) != 0);
    const bool want = (v + 1 < hi) && (((v + 1) & 3) != 0);
    gla_pre(p, l, v >> 2, v & 3, qn, fn, vv, have, want);
  }
}

__device__ void phase_seq(const KP& p, int l) {
  for (int u = p.bid; u < 512; u += p.nblk) {
    int uu = u & 255, soff = (u >= 256) ? 8 : 0;
    if (uu < 128) ssd_seq(p, l, soff + (uu >> 4), (uu & 15) >> 1, uu & 1);
    else { int v = uu - 128; gla_seq(p, l, soff + (v >> 4), (v & 15) >> 2, v & 3); }
    __syncthreads();
  }
}


#define XB_TMO      128
#define XB_XCNT(j)  (256  + 64 * (j))
#define XB_XSUB(j)  (1280 + 64 * (j))
#define XB_XGEN(j)  (2304 + 64 * (j))
#define XB_TOP      3328
#define XB_TOPGEN   3392
#define XCD_BAR_WORDS 3456
#define XB_SPIN_CAP (1u << 18)
#define LAS __attribute__((address_space(3)))
__device__ __forceinline__ unsigned xb_ld(unsigned* p)              { return __hip_atomic_load(p, __ATOMIC_RELAXED, __HIP_MEMORY_SCOPE_AGENT); }
__device__ __forceinline__ unsigned xb_add(unsigned* p, unsigned v) { return __hip_atomic_fetch_add(p, v, __ATOMIC_RELAXED, __HIP_MEMORY_SCOPE_AGENT); }
__device__ __forceinline__ unsigned xb_xcc_id() { return (unsigned)__builtin_amdgcn_s_getreg((3 << 11) | 20) & 0xFu; }
#define XB_SPIN(cond, bar) do { unsigned _sp = 0; while (cond) { __builtin_amdgcn_s_sleep(1); \
    if ((++_sp & 255u) == 0u) { if (xb_ld(&(bar)[XB_TMO])) break; if (_sp > XB_SPIN_CAP) { atomicAdd(&(bar)[XB_TMO], 1u); break; } } } } while (0)
struct XcdBarrier { unsigned* bar; unsigned x; volatile LAS unsigned* st; };
__device__ __forceinline__ XcdBarrier xcd_barrier_post(unsigned* bar, volatile LAS unsigned* st) {
  XcdBarrier b; b.bar = bar; b.x = xb_xcc_id(); b.st = st;
  if (threadIdx.x == 0) (void)xb_add(&bar[XB_XCNT(b.x)], 1u);
  return b;
}
__device__ __forceinline__ void xcd_barrier_complete(unsigned* bar, unsigned x, unsigned& nloc, unsigned& nx) {
  const unsigned G = gridDim.x * gridDim.y * gridDim.z;
  unsigned sum, cnt, mine, sp = 0u;
  for (;;) {
    sum = 0u; cnt = 0u; mine = 0u;
#pragma unroll
    for (unsigned j = 0; j < 16; ++j) { const unsigned c = xb_ld(&bar[XB_XCNT(j)]); sum += c; cnt += (c > 0u) ? 1u : 0u; mine = (j == x) ? c : mine; }
    if (sum == G) break;
    __builtin_amdgcn_s_sleep(1);
    if ((++sp & 255u) == 0u) { if (xb_ld(&bar[XB_TMO])) break; if (sp > XB_SPIN_CAP) { atomicAdd(&bar[XB_TMO], 1u); break; } }
  }
  nloc = mine > 0u ? mine : 1u; nx = cnt > 0u ? cnt : 1u;
}
__device__ __forceinline__ void xcd_barrier(const XcdBarrier& b) {
  asm volatile("s_waitcnt vmcnt(0)" ::: "memory");
  __syncthreads();
  if (threadIdx.x == 0) {
    unsigned* bar = b.bar; asm volatile("" : "+s"(bar));
    __builtin_amdgcn_s_waitcnt(0);
    unsigned nloc = b.st[0], nx = b.st[1];
    if (nloc == 0u) { xcd_barrier_complete(bar, b.x, nloc, nx); b.st[0] = nloc; b.st[1] = nx; }
    const unsigned old = xb_add(&bar[XB_XSUB(b.x)], 1u);
    const unsigned gen = old / nloc;
    if (old + 1u == (gen + 1u) * nloc) {
      __builtin_amdgcn_fence(__ATOMIC_RELEASE, "agent");
      asm volatile("s_waitcnt vmcnt(0)" ::: "memory");
      const unsigned og = xb_add(&bar[XB_TOP], 1u);
      const unsigned tg = og / nx;
      if (og + 1u == (tg + 1u) * nx) xb_add(&bar[XB_TOPGEN], 1u);
      else XB_SPIN(xb_ld(&bar[XB_TOPGEN]) == tg, bar);
      __builtin_amdgcn_fence(__ATOMIC_ACQUIRE, "agent");
      xb_add(&bar[XB_XGEN(b.x)], 1u);
      asm volatile("s_waitcnt vmcnt(0)" ::: "memory");
    } else {
      XB_SPIN(xb_ld(&bar[XB_XGEN(b.x)]) == gen, bar);
      __builtin_amdgcn_fence(__ATOMIC_ACQUIRE, "agent");
      asm volatile("s_waitcnt vmcnt(0)" ::: "memory");
    }
  }
  __syncthreads();
}

__device__ void run_phase(const KP& p_, int ph) {
  KP p = p_;
  {
    unsigned long long w_ = (unsigned long long)p_.ws, o_ = (unsigned long long)p_.out;
    unsigned wl = __builtin_amdgcn_readfirstlane((unsigned)w_), wh = __builtin_amdgcn_readfirstlane((unsigned)(w_ >> 32));
    unsigned ol = __builtin_amdgcn_readfirstlane((unsigned)o_), oh = __builtin_amdgcn_readfirstlane((unsigned)(o_ >> 32));
    int b_ = __builtin_amdgcn_readfirstlane((int)blockIdx.x), n_ = __builtin_amdgcn_readfirstlane((int)gridDim.x);
    asm volatile("" : "+s"(wl), "+s"(wh), "+s"(ol), "+s"(oh), "+s"(b_), "+s"(n_));
    p.ws = (unsigned char*)(__attribute__((address_space(1))) unsigned char*)(((unsigned long long)wh << 32) | (unsigned long long)wl);
    p.out = (float*)(__attribute__((address_space(1))) float*)(((unsigned long long)oh << 32) | (unsigned long long)ol);
    p.bid = b_; p.nblk = n_;
  }
  const bfr* W = (const bfr*)(p.ws + OFF_W);
  const bfr* hb = (const bfr*)(p.ws + OFF_HB);
  const bfr* U = (const bfr*)(p.ws + OFF_U);
  const bfr* mix = (const bfr*)(p.ws + OFF_MIX);
  int plo = 0, phi = 0, pfirst = 16;
  if (ph == 0) { phi = 1408; pfirst = 0; }
  else {
    int l = (ph - 1) / 12, q = (ph - 1) % 12;
    const bfr* Wl = W + (size_t)l * W_LAYER;
    if (q == 2 || q == 8 || (q == 11 && l == 0)) { phase_stat(p); return; }
    if (q == 11) { phase_final(p); return; }
    if (q == 4) { phase_pre(p, l); return; }
    if (q == 5) { phase_seq(p, l); return; }
    if (q == 6) { phase_mixnorm(p, l); return; }
    if (q == 0) { gemm_phase<1, NGU, DM>(p, l, hb, Wl + W_GUA); if (l == 0) { plo = 1408; phi = 2112; pfirst = (132 * 22) % p.nblk; } }
    else if (q == 1) { gemm_phase<2, DM, DFF>(p, l, U, Wl + W_DA); if (l == 0) { plo = 2112; phi = 5440; } else { plo = 7552; phi = 10880; } }
    else if (q == 3) gemm_phase<3, NINP, DM>(p, l, hb, Wl + W_IN);
    else if (q == 7) { gemm_phase<2, DM, DM>(p, l, mix, Wl + W_OUT); if (l == 0) { plo = 5440; phi = 6140; } }
    else if (q == 9) gemm_phase<1, NGU, DM>(p, l, hb, Wl + W_GUB);
    else { gemm_phase<2, DM, DFF>(p, l, U, Wl + W_DB); if (l == 0) { plo = 6140; phi = 7552; } }
  }
  if (phi > plo) { __syncthreads(); phase_prep(p, plo, phi, pfirst); }
  if (ph == 0) phase_init(p);
}

__global__ void __launch_bounds__(512, 2) hymba_fwd(KP p) {
  extern __shared__ __attribute__((aligned(16))) unsigned char smem[];
  volatile LAS unsigned* st = (volatile LAS unsigned*)(smem + 131072);
  if (threadIdx.x == 0) { st[0] = 0u; st[1] = 0u; }
  __syncthreads();
  XcdBarrier xb = xcd_barrier_post((unsigned*)(p.ws + OFF_BAR), st);
  for (int ph = p.ph_lo; ph < p.ph_hi; ++ph) {
    run_phase(p, ph);
    if (ph + 1 < p.ph_hi) { if (ph < 0) cg::this_grid().sync(); else xcd_barrier(xb); }
  }
}

extern "C" void kernel_launch(void* const* d_in, const int* in_sizes, int n_in, void* d_out, int out_size,
                              void* d_ws, size_t ws_size, hipStream_t stream) {
  static int grid = 0;
  if (!grid) {
    int dev = 0, cus = 0, per_cu = 0;
    hipGetDevice(&dev);
    hipDeviceGetAttribute(&cus, hipDeviceAttributeMultiprocessorCount, dev);
    hipFuncSetAttribute((const void*)hymba_fwd, hipFuncAttributeMaxDynamicSharedMemorySize, LDS_BYTES);
    hipOccupancyMaxActiveBlocksPerMultiprocessor(&per_cu, (const void*)hymba_fwd, 512, LDS_BYTES);
    if (per_cu < 1) per_cu = 1;
    grid = cus * per_cu;
    if (grid > 256) grid = 256;
  }
  hipMemsetAsync((char*)d_ws + OFF_BAR, 0, XCD_BAR_WORDS * 4, stream);
  KP p{};
  for (int i = 0; i < 26; ++i) p.in[i] = (const float*)d_in[i];
  p.out = (float*)d_out; p.ws = (unsigned char*)d_ws;
#if SINGLE_LAUNCH
  p.ph_lo = 0; p.ph_hi = NPHASE;
  void* args[] = {&p};
  hipError_t e = hipLaunchCooperativeKernel((const void*)hymba_fwd, dim3(grid), dim3(512), args, LDS_BYTES, stream);
  if (e != hipSuccess) fprintf(stderr, "cooperative launch failed: %s (grid %d)\n", hipGetErrorString(e), grid);
#else
  for (int ph = 0; ph < NPHASE; ++ph) {
    p.ph_lo = ph; p.ph_hi = ph + 1;
    hipLaunchKernelGGL(hymba_fwd, dim3(grid), dim3(512), LDS_BYTES, stream, p);
  }
#endif
}
```
